# Optimizing an MI355X kernel written in HIP

```python
import jax, jax.numpy as jnp
from jax import lax
import numpy as np

D_MODEL = 1024
BATCH = 8
SEQ = 4096
DEPTH = 4

N_META = 16
BLOCK = 128
N_PAD = (-N_META) % BLOCK

SB_HEADS = 8
SB_HEAD_DIM = 64
MLA_HEADS = 8
MLA_NOPE = 64
MLA_ROPE = 32
MLA_V = 64
MLA_Q_LORA = 384
MLA_KV_LORA = 256
RET_HEADS = 4
RET_QK = 64
RET_V = 128

D_SB = SB_HEADS * SB_HEAD_DIM
D_MLA = MLA_HEADS * MLA_V
D_RET = RET_HEADS * RET_V
D_MIX = D_SB + D_MLA + D_RET
D_FF = 4 * D_MODEL

IN_SIZES = (D_SB, D_SB, D_SB,
            MLA_Q_LORA, MLA_KV_LORA, MLA_ROPE,
            RET_HEADS * RET_QK, RET_HEADS * RET_QK, D_RET, D_RET)
IN_SPLITS = tuple(int(s) for s in np.cumsum(IN_SIZES)[:-1])
N_IN = int(sum(IN_SIZES))

ROPE_THETA = 10000.0
LN_EPS = 1e-5
DN_ALPHA = (2 * DEPTH) ** 0.25
DN_BETA = (8 * DEPTH) ** -0.25
RET_GAMMA = tuple(1.0 - 2.0 ** (-5 - h) for h in range(RET_HEADS))

kernel_name = "hybrid_sb_mla_retention_deepnorm"


def layer_norm(x, g, b):
    x32 = x.astype(jnp.float32)
    mu = jnp.mean(x32, -1, keepdims=True)
    var = jnp.mean(jnp.square(x32 - mu), -1, keepdims=True)
    y = (x32 - mu) * lax.rsqrt(var + LN_EPS)
    return (y * g.astype(jnp.float32) + b.astype(jnp.float32)).astype(x.dtype)


def rms_norm(x, g):
    x32 = x.astype(jnp.float32)
    y = x32 * lax.rsqrt(jnp.mean(jnp.square(x32), -1, keepdims=True) + LN_EPS)
    return (y * g.astype(jnp.float32)).astype(x.dtype)


def head_norm(y):
    y32 = y.astype(jnp.float32)
    mu = jnp.mean(y32, -1, keepdims=True)
    var = jnp.mean(jnp.square(y32 - mu), -1, keepdims=True)
    return (y32 - mu) * lax.rsqrt(var + LN_EPS)


def apply_rope(x, pos):
    half = x.shape[-1] // 2
    inv = ROPE_THETA ** (-jnp.arange(half, dtype=jnp.float32) / half)
    ang = pos[:, None] * inv[None, :]
    cos = jnp.cos(ang)[:, None, :]
    sin = jnp.sin(ang)[:, None, :]
    x1, x2 = x[..., :half], x[..., half:]
    return jnp.concatenate([x1 * cos - x2 * sin, x1 * sin + x2 * cos], -1).astype(x.dtype)


def stick_breaking_attention(q, k, v, valid):
    L, d = q.shape[1], q.shape[-1]
    scale = d ** -0.5
    outs = []
    for i in range(L // BLOCK):
        q0, q1 = i * BLOCK, (i + 1) * BLOCK
        z = jnp.einsum("bqhd,bkhd->bhqk", q[:, q0:q1], k[:, :q1]).astype(jnp.float32) * scale
        t_idx = jnp.arange(q0, q1)[:, None]
        s_idx = jnp.arange(q1)[None, :]
        mask = (s_idx < t_idx) & valid[None, :q1]
        log_beta = jnp.where(mask, jax.nn.log_sigmoid(z), -jnp.inf)
        log_keep = jnp.where(mask, jax.nn.log_sigmoid(-z), 0.0)
        incl = lax.cumsum(log_keep, axis=3, reverse=True)
        excl = jnp.concatenate([incl[..., 1:], jnp.zeros_like(incl[..., :1])], axis=-1)
        w = jnp.exp(log_beta + excl)
        outs.append(jnp.einsum("bhqk,bkhd->bqhd", w.astype(v.dtype), v[:, :q1]))
    return jnp.concatenate(outs, axis=1)


def mla_attention(q_nope, q_rope, k_nope, k_rope, v, valid):
    L = q_nope.shape[1]
    scale = (MLA_NOPE + MLA_ROPE) ** -0.5
    outs = []
    for i in range(L // BLOCK):
        q0, q1 = i * BLOCK, (i + 1) * BLOCK
        s = (jnp.einsum("bqhd,bkhd->bhqk", q_nope[:, q0:q1], k_nope[:, :q1])
             + jnp.einsum("bqhd,bkd->bhqk", q_rope[:, q0:q1], k_rope[:, :q1])).astype(jnp.float32) * scale
        t_idx = jnp.arange(q0, q1)[:, None]
        s_idx = jnp.arange(q1)[None, :]
        mask = (s_idx <= t_idx) & (valid[None, :q1] | (s_idx == t_idx))
        p = jax.nn.softmax(jnp.where(mask, s, -jnp.inf), axis=-1)
        outs.append(jnp.einsum("bhqk,bkhd->bqhd", p.astype(v.dtype), v[:, :q1]))
    return jnp.concatenate(outs, axis=1)


def multiscale_retention(q, k, v):
    B, L, H, dk = q.shape
    dv = v.shape[-1]
    n = L // BLOCK
    log_g = jnp.log(jnp.array(RET_GAMMA, jnp.float32))
    idx = jnp.arange(BLOCK, dtype=jnp.float32)
    diff = idx[:, None] - idx[None, :]
    d_in = jnp.where(diff[None] >= 0, jnp.exp(jnp.maximum(diff, 0.0)[None] * log_g[:, None, None]), 0.0)
    q_decay = jnp.exp((idx[:, None] + 1.0) * log_g[None, :])
    k_decay = jnp.exp((BLOCK - 1.0 - idx[:, None]) * log_g[None, :])
    c_decay = jnp.exp(BLOCK * log_g)

    def to_chunks(a):
        return jnp.moveaxis(a.astype(jnp.float32).reshape(B, n, BLOCK, H, a.shape[-1]), 1, 0)

    def step(state, inp):
        qc, kc, vc = inp
        inner = jnp.einsum("bqhd,bkhd->bhqk", qc, kc) * d_in[None]
        y = (jnp.einsum("bhqk,bkhe->bqhe", inner, vc)
             + jnp.einsum("bqhd,bhde->bqhe", qc, state) * q_decay[None, :, :, None])
        state = (state * c_decay[None, :, None, None]
                 + jnp.einsum("bkhd,bkhe->bhde", kc * k_decay[None, :, :, None], vc))
        return state, y

    state0 = jnp.zeros((B, H, dk, dv), jnp.float32)
    _, ys = lax.scan(step, state0, (to_chunks(q), to_chunks(k), to_chunks(v)))
    return jnp.moveaxis(ys, 0, 1).reshape(B, L, H, dv)


def hybrid_mixer(h, w_in, q_norm_g, kv_norm_g, w_uq, w_ukv, w_out, pos, valid):
    B, L, _ = h.shape
    proj = h @ w_in
    sb_q, sb_k, sb_v, c_q, c_kv, k_r, r_q, r_k, r_v, r_g = jnp.split(proj, IN_SPLITS, axis=-1)

    hs = lambda a, nh: a.reshape(B, L, nh, -1)
    out_a = stick_breaking_attention(hs(sb_q, SB_HEADS), hs(sb_k, SB_HEADS), hs(sb_v, SB_HEADS), valid)

    q = (rms_norm(c_q, q_norm_g) @ w_uq).reshape(B, L, MLA_HEADS, MLA_NOPE + MLA_ROPE)
    q_nope, q_rope = q[..., :MLA_NOPE], apply_rope(q[..., MLA_NOPE:], pos)
    kv = (rms_norm(c_kv, kv_norm_g) @ w_ukv).reshape(B, L, MLA_HEADS, MLA_NOPE + MLA_V)
    k_nope, v_b = kv[..., :MLA_NOPE], kv[..., MLA_NOPE:]
    k_rope = apply_rope(k_r[:, :, None, :], pos)[:, :, 0]
    out_b = mla_attention(q_nope, q_rope, k_nope, k_rope, v_b, valid)

    rq = apply_rope(hs(r_q, RET_HEADS), pos)
    rk = apply_rope(hs(r_k, RET_HEADS), pos) * (RET_QK ** -0.5)
    rk = jnp.where(valid[None, :, None, None], rk, jnp.zeros_like(rk))
    y_c = head_norm(multiscale_retention(rq, rk, hs(r_v, RET_HEADS))).reshape(B, L, D_RET)
    out_c = (jax.nn.silu(r_g.astype(jnp.float32)) * y_c).astype(h.dtype)

    mixed = jnp.concatenate([out_a.reshape(B, L, D_SB), out_b.reshape(B, L, D_MLA), out_c], axis=-1)
    return mixed @ w_out


def squared_relu_mlp(h, w1, w2):
    return jnp.square(jax.nn.relu(h @ w1)) @ w2


def setup_inputs(seed: int = 0) -> dict:
    key = jax.random.key(seed)
    ks = jax.random.split(key, 16)
    f32 = jnp.float32

    def nrm(k, shape, std):
        return jax.random.normal(k, shape, f32) * std

    return {
        "x": nrm(ks[0], (BATCH, SEQ, D_MODEL), 1.0),
        "meta_tokens": nrm(ks[1], (N_META, D_MODEL), 1.0),
        "ln_emb_g": 1.0 + nrm(ks[2], (D_MODEL,), 0.02),
        "ln_emb_b": nrm(ks[3], (D_MODEL,), 0.02),
        "w_in": nrm(ks[4], (DEPTH, D_MODEL, N_IN), D_MODEL ** -0.5),
        "mla_q_norm": 1.0 + nrm(ks[5], (DEPTH, MLA_Q_LORA), 0.02),
        "mla_kv_norm": 1.0 + nrm(ks[6], (DEPTH, MLA_KV_LORA), 0.02),
        "w_uq": nrm(ks[7], (DEPTH, MLA_Q_LORA, MLA_HEADS * (MLA_NOPE + MLA_ROPE)), MLA_Q_LORA ** -0.5),
        "w_ukv": nrm(ks[8], (DEPTH, MLA_KV_LORA, MLA_HEADS * (MLA_NOPE + MLA_V)), MLA_KV_LORA ** -0.5),
        "w_out": nrm(ks[9], (DEPTH, D_MIX, D_MODEL), DN_BETA * D_MIX ** -0.5),
        "ln1_g": 1.0 + nrm(ks[10], (DEPTH, D_MODEL), 0.02),
        "ln1_b": nrm(ks[11], (DEPTH, D_MODEL), 0.02),
        "w_ff1": nrm(ks[12], (DEPTH, D_MODEL, D_FF), D_MODEL ** -0.5),
        "w_ff2": nrm(ks[13], (DEPTH, D_FF, D_MODEL), DN_BETA * D_FF ** -0.5),
        "ln2_g": 1.0 + nrm(ks[14], (DEPTH, D_MODEL), 0.02),
        "ln2_b": nrm(ks[15], (DEPTH, D_MODEL), 0.02),
    }


def reference(x, meta_tokens, ln_emb_g, ln_emb_b, w_in, mla_q_norm, mla_kv_norm, w_uq, w_ukv, w_out,
              ln1_g, ln1_b, w_ff1, w_ff2, ln2_g, ln2_b):
    B, S, _ = x.shape
    meta = jnp.broadcast_to(meta_tokens[None].astype(x.dtype), (B, N_META, D_MODEL))
    pad = jnp.zeros((B, N_PAD, D_MODEL), x.dtype)
    h = jnp.concatenate([pad, meta, x], axis=1)
    L = h.shape[1]
    pos_i = jnp.arange(L) - N_PAD
    valid = pos_i >= 0
    pos = pos_i.astype(jnp.float32)
    h = layer_norm(h, ln_emb_g, ln_emb_b)
    for l in range(DEPTH):
        mix = hybrid_mixer(h, w_in[l], mla_q_norm[l], mla_kv_norm[l], w_uq[l], w_ukv[l], w_out[l], pos, valid)
        h = layer_norm(DN_ALPHA * h + mix, ln1_g[l], ln1_b[l])
        h = layer_norm(DN_ALPHA * h + squared_relu_mlp(h, w_ff1[l], w_ff2[l]), ln2_g[l], ln2_b[l])
    return h[:, N_PAD + N_META:]
```

```cpp
#include <hip/hip_runtime.h>
#include <hip/hip_cooperative_groups.h>
#include <cstdio>
#include <cstdint>
namespace cg = cooperative_groups;
#ifndef MK_SPLIT
#define MK_SPLIT 0
#endif
namespace pg8 {
#define PG8_LAS __attribute__((address_space(3)))
typedef unsigned short bf16_t;
typedef short bf16x8 __attribute__((ext_vector_type(8)));
typedef float f32x4 __attribute__((ext_vector_type(4)));
typedef unsigned u32x4 __attribute__((ext_vector_type(4)));
constexpr int BM = 256, BK = 64, HALF = 128, HTB = HALF * BK * 2  , STAGE_BYTES = 8 * HTB, NXCD = 8, WGM = 8;

__host__ __device__ __forceinline__ int lds_byte(int r, int c) { const int st = (r >> 4) * 2 + (c >> 5), rr = r & 15, cc = c & 31, ob = rr * 64 + cc * 2; return st * 1024 + (ob ^ (((ob >> 9) & 1) << 5)); }
__host__ __device__ __forceinline__ void stage_rc(int b, int& R, int& C) { const int st = b / 1024, sb = b % 1024, swz = sb ^ (((sb >> 9) & 1) << 5); R = (st >> 1) * 16 + swz / 64; C = (st & 1) * 32 + (swz % 64) / 2; }
__host__ __device__ __forceinline__ int perm32(int rho) { const int n = rho >> 4, i = rho & 15; return 8 * (i >> 2) + 4 * n + (i & 3); }

struct Unit { int pm, pn, kt0; };
struct Gemm { const bf16_t* A; const bf16_t* Bt; int M, N, K, ld; };

struct StaticOrder {
    int nM, nN, nwg, G, c;
    __host__ __device__ void init(int M, int N, int G_, int c_) { nM = M / BM; nN = N / BM; nwg = nM * nN; G = G_; c = c_; }
    __host__ __device__ bool next(int i, Unit& u) const {
        const long L = (long)i * G + c; if (L >= nwg) return false;
        int wgid = (int)L; { const int q = nwg / NXCD, r = nwg % NXCD, xcd = wgid % NXCD, off = wgid / NXCD; wgid = (xcd < r ? xcd * (q + 1) : r * (q + 1) + (xcd - r) * q) + off; }
        const int nig = WGM * nN, gid = wgid / nig, fm = gid * WGM, gsz = (nM - fm) < WGM ? (nM - fm) : WGM;
        u.pm = fm + ((wgid % nig) % gsz); u.pn = (wgid % nig) / gsz; u.kt0 = 0; return true;
    }
    __device__ __forceinline__ void a_ready(const Unit&) const {}
    __device__ __forceinline__ void done(const Unit&) const {}
};
template <class Epi, class Sched, bool ALIGN_EPI = false, bool SP2 = false>
__device__ __forceinline__ void gemm_phase(PG8_LAS unsigned char* lds, const Gemm g, const Sched& S, const Epi& E) {
    int tid_l = threadIdx.x; asm volatile("" : "+v"(tid_l));
    const int tid = tid_l, wid = __builtin_amdgcn_readfirstlane(tid >> 6), lane = tid & 63, wr = wid >> 2, wc = wid & 3, fr = lane & 15, fq = lane >> 4;
    const int K = g.K, nt = K / BK;
    unsigned voffA[2], voffB[2];
#pragma unroll
    for (int i = 0; i < 2; ++i) { int R, C; stage_rc(tid * 16 + i * 8192, R, C); const int Rb = Epi::PERM ? ((R & ~31) + perm32(R & 31)) : R;
        voffA[i] = (unsigned)(R * g.ld + C) * 2u; voffB[i] = (unsigned)(Rb * g.ld + C) * 2u; }
    const size_t kstep = (size_t)(BK * 2);
    const size_t hstep = (size_t)HALF * g.ld * 2;
    const size_t tstep = 2 * hstep;
    const unsigned ldsw = (unsigned)wid * 1024u;
    const int aoff = lds_byte(wr * 64 + fr, fq * 8), boff = lds_byte(wc * 32 + fr, fq * 8);
#define PG8_SA(b, h) (((b) * 2 + (h)) * HTB)
#define PG8_SB(b, h) ((4 + (b) * 2 + (h)) * HTB)
#define PG8_STAGE(bufoff, gbase, voff) do { _Pragma("unroll") for (int _i = 0; _i < 2; ++_i) \
        __builtin_amdgcn_global_load_lds((const unsigned*)((const char*)(gbase) + (voff)[_i]), (PG8_LAS unsigned*)(lds + (bufoff) + ldsw + _i * 8192), 16, 0, 0); } while (0)
#define PG8_LDA(dst, b, h) do { _Pragma("unroll") for (int m = 0; m < 4; ++m) _Pragma("unroll") for (int k = 0; k < 2; ++k) dst[m][k] = *(const PG8_LAS bf16x8*)(lds + PG8_SA(b, h) + aoff + m * 2048 + k * 1024); } while (0)
#define PG8_LDB(dst, b, h) do { _Pragma("unroll") for (int n = 0; n < 2; ++n) _Pragma("unroll") for (int k = 0; k < 2; ++k) dst[n][k] = *(const PG8_LAS bf16x8*)(lds + PG8_SB(b, h) + boff + n * 2048 + k * 1024); } while (0)
#define PG8_MMA(ai, bj, At, Bt) do { __builtin_amdgcn_s_setprio(1); _Pragma("unroll") for (int m = 0; m < 4; ++m) _Pragma("unroll") for (int n = 0; n < 2; ++n) _Pragma("unroll") for (int k = 0; k < 2; ++k) \
        acc[ai][bj][m][n] = __builtin_amdgcn_mfma_f32_16x16x32_bf16(Bt[n][k], At[m][k], acc[ai][bj][m][n], 0, 0, 0); __builtin_amdgcn_s_setprio(0); } while (0)
#define PG8_WAIT_V(n) asm volatile("s_waitcnt vmcnt(" #n ")" ::: "memory")
#define PG8_WAIT_L(n) asm volatile("s_waitcnt lgkmcnt(" #n ")" ::: "memory")
#define PG8_BAR __builtin_amdgcn_s_barrier()
#define PG8_SCHED __builtin_amdgcn_sched_barrier(0)
    Unit cur, nxt; int ui = 0;
    if (!S.next(0, cur)) return;
    f32x4 acc[2][2][4][2];
#pragma unroll
    for (int a = 0; a < 2; ++a)
#pragma unroll
        for (int b = 0; b < 2; ++b)
#pragma unroll
            for (int m = 0; m < 4; ++m)
#pragma unroll
                for (int n = 0; n < 2; ++n) acc[a][b][m][n] = (f32x4){0.f, 0.f, 0.f, 0.f};
    bf16x8 At[4][2], B0[2][2], B1[2][2];
    const char* cA = (const char*)g.A + (size_t)cur.pm * tstep + (size_t)cur.kt0 * kstep; const char* cB = (const char*)g.Bt + (size_t)cur.pn * tstep + (size_t)cur.kt0 * kstep;
    S.a_ready(cur);
    if constexpr (SP2) {
        PG8_STAGE(PG8_SB(0, 0), cB, voffB); PG8_STAGE(PG8_SB(0, 1), cB + hstep, voffB); PG8_STAGE(PG8_SA(0, 0), cA, voffA); PG8_STAGE(PG8_SA(0, 1), cA + hstep, voffA);
        if (wr == 1) PG8_BAR;
        PG8_WAIT_V(2); PG8_BAR;
        PG8_STAGE(PG8_SB(1, 0), cB + kstep, voffB); PG8_STAGE(PG8_SA(1, 0), cA + kstep, voffA); PG8_STAGE(PG8_SB(1, 1), cB + hstep + kstep, voffB);
        PG8_WAIT_V(6); PG8_BAR;
    } else {
        PG8_STAGE(PG8_SB(0, 0), cB, voffB); PG8_STAGE(PG8_SA(0, 0), cA, voffA); PG8_STAGE(PG8_SB(0, 1), cB + hstep, voffB); PG8_STAGE(PG8_SA(0, 1), cA + hstep, voffA);
        if (wr == 1) PG8_BAR;
        PG8_WAIT_V(4); PG8_BAR;
        PG8_STAGE(PG8_SB(1, 0), cB + kstep, voffB); PG8_STAGE(PG8_SA(1, 0), cA + kstep, voffA); PG8_STAGE(PG8_SB(1, 1), cB + hstep + kstep, voffB);
        PG8_WAIT_V(6); PG8_BAR;
    }
    for (;;) {
        const bool has_next = S.next(ui + 1, nxt);
        const char* nA = has_next ? (const char*)g.A + (size_t)nxt.pm * tstep + (size_t)nxt.kt0 * kstep : cA; const char* nB = has_next ? (const char*)g.Bt + (size_t)nxt.pn * tstep + (size_t)nxt.kt0 * kstep : cB;
        for (int t = 0; t < nt; t += 2) {
            const bool last = (t == nt - 2);
            const char* a1 = cA + (size_t)(t + 1) * kstep;
            const char* a2 = last ? nA : cA + (size_t)(t + 2) * kstep; const char* b2 = last ? nB : cB + (size_t)(t + 2) * kstep;
            const char* a3 = a2 + kstep; const char* b3 = b2 + kstep;
            if (last && has_next) S.a_ready(nxt);
            if constexpr (SP2) {
            PG8_LDB(B0, 0, 0); PG8_LDB(B1, 0, 1); PG8_SCHED; PG8_LDA(At, 0, 0); PG8_STAGE(PG8_SA(1, 1), a1 + hstep, voffA);
            PG8_WAIT_V(8); PG8_WAIT_L(0); PG8_BAR; PG8_MMA(0, 0, At, B0); PG8_MMA(0, 1, At, B1); PG8_BAR; PG8_SCHED;
            PG8_LDA(At, 0, 1); PG8_STAGE(PG8_SB(0, 0), b2, voffB); PG8_STAGE(PG8_SB(0, 1), b2 + hstep, voffB); PG8_STAGE(PG8_SA(0, 0), a2, voffA);
            PG8_WAIT_V(8); PG8_WAIT_L(0); PG8_BAR; PG8_MMA(1, 0, At, B0); PG8_MMA(1, 1, At, B1); PG8_BAR; PG8_SCHED;
            PG8_LDB(B0, 1, 0); PG8_LDB(B1, 1, 1); PG8_SCHED; PG8_LDA(At, 1, 0); PG8_STAGE(PG8_SA(0, 1), a2 + hstep, voffA);
            PG8_WAIT_V(8); PG8_WAIT_L(0); PG8_BAR; PG8_MMA(0, 0, At, B0); PG8_MMA(0, 1, At, B1); PG8_BAR; PG8_SCHED;
            PG8_LDA(At, 1, 1); PG8_STAGE(PG8_SB(1, 0), b3, voffB); PG8_STAGE(PG8_SB(1, 1), b3 + hstep, voffB); PG8_STAGE(PG8_SA(1, 0), a3, voffA);
            PG8_WAIT_V(8); PG8_WAIT_L(0); PG8_BAR; PG8_MMA(1, 0, At, B0); PG8_MMA(1, 1, At, B1); PG8_BAR; PG8_SCHED;
            } else {
            PG8_LDB(B0, 0, 0); PG8_SCHED; PG8_LDA(At, 0, 0); PG8_STAGE(PG8_SA(1, 1), a1 + hstep, voffA);
            PG8_WAIT_L(8); PG8_BAR; PG8_WAIT_L(0); PG8_MMA(0, 0, At, B0); PG8_BAR; PG8_SCHED;
            PG8_LDB(B1, 0, 1); PG8_STAGE(PG8_SB(0, 0), b2, voffB);
            PG8_BAR; PG8_WAIT_L(0); PG8_MMA(0, 1, At, B1); PG8_BAR;
            PG8_LDA(At, 0, 1); PG8_STAGE(PG8_SA(0, 0), a2, voffA);
            PG8_BAR; PG8_WAIT_L(0); PG8_MMA(1, 0, At, B0); PG8_BAR; PG8_SCHED;
            PG8_STAGE(PG8_SB(0, 1), b2 + hstep, voffB);
            PG8_WAIT_V(6); PG8_BAR; PG8_MMA(1, 1, At, B1); PG8_BAR;
            PG8_LDB(B0, 1, 0); PG8_SCHED; PG8_LDA(At, 1, 0); PG8_STAGE(PG8_SA(0, 1), a2 + hstep, voffA);
            PG8_WAIT_L(8); PG8_BAR; PG8_WAIT_L(0); PG8_MMA(0, 0, At, B0); PG8_BAR; PG8_SCHED;
            PG8_LDB(B1, 1, 1); PG8_STAGE(PG8_SB(1, 0), b3, voffB);
            PG8_BAR; PG8_WAIT_L(0); PG8_MMA(0, 1, At, B1); PG8_BAR;
            PG8_LDA(At, 1, 1); PG8_STAGE(PG8_SA(1, 0), a3, voffA);
            PG8_BAR; PG8_WAIT_L(0); PG8_MMA(1, 0, At, B0); PG8_BAR; PG8_SCHED;
            PG8_STAGE(PG8_SB(1, 1), b3 + hstep, voffB);
            PG8_WAIT_V(6); PG8_BAR; PG8_MMA(1, 1, At, B1); PG8_BAR;
            }
        }
        if constexpr (ALIGN_EPI) { if (wr == 0) PG8_BAR; }
        if constexpr (!Epi::AFTER_DRAIN) { E(acc, cur, wr, wc, fr, fq); S.done(cur); }
        if (!has_next) break;
#pragma unroll
        for (int a = 0; a < 2; ++a)
#pragma unroll
            for (int b = 0; b < 2; ++b)
#pragma unroll
                for (int m = 0; m < 4; ++m)
#pragma unroll
                    for (int n = 0; n < 2; ++n) acc[a][b][m][n] = (f32x4){0.f, 0.f, 0.f, 0.f};
        cur = nxt; cA = nA; cB = nB; ++ui;
        if constexpr (ALIGN_EPI) { if (wr == 1) PG8_BAR; }
    }
    PG8_WAIT_V(0);
    if constexpr (!ALIGN_EPI) { if (wr == 0) PG8_BAR; }
    PG8_BAR;
    if constexpr (Epi::AFTER_DRAIN) { E.fused(acc, cur, wr, wc, fr, fq, lds, wid, lane); S.done(cur); }
#undef PG8_SA
#undef PG8_SB
#undef PG8_STAGE
#undef PG8_LDA
#undef PG8_LDB
#undef PG8_MMA
#undef PG8_WAIT_V
#undef PG8_WAIT_L
#undef PG8_BAR
#undef PG8_SCHED
}
}

constexpr int BATCH = 8, SEQ = 4096, DM = 1024, DEPTH = 4, NPAD = 112, LSEQ = 4224, MROWS = BATCH * LSEQ;
constexpr int NIN_LOG = 3744, NIN = 3840, DFF = 4096, DMIX = 1536;
constexpr float LN_EPS = 1e-5f, DN_ALPHA = 1.681792830507429f;
constexpr int NWAVES = 8, NTHREADS = 512;
constexpr int LDS_BYTES = 147456;
constexpr int NPHASES = 1 + 8 * DEPTH;

typedef unsigned short bf16;
typedef float f32x4 __attribute__((ext_vector_type(4)));
typedef float f32x2 __attribute__((ext_vector_type(2)));
typedef float f32x16 __attribute__((ext_vector_type(16)));
typedef short bf16x8 __attribute__((ext_vector_type(8)));
typedef unsigned u32x2 __attribute__((ext_vector_type(2)));
typedef unsigned u32x4 __attribute__((ext_vector_type(4)));
typedef __bf16 bf16x2_t __attribute__((ext_vector_type(2)));
#define LAS __attribute__((address_space(3)))

constexpr size_t MiB = 1u << 20;
constexpr size_t WS_H = 0, WS_HB = 132 * MiB, WS_W = 198 * MiB, WS_MISC = 226 * MiB, WS_B = 230 * MiB, WS_PART = 494 * MiB, WS_END = 510 * MiB;
constexpr size_t W_IN = 0, W_UQ = W_IN + (size_t)NIN * 1024 * 2, W_UKV = W_UQ + (size_t)768 * 384 * 2, W_OUT = W_UKV + (size_t)1024 * 256 * 2,
                 W_FF1 = W_OUT + (size_t)1024 * 1536 * 2, W_FF2 = W_FF1 + (size_t)4096 * 1024 * 2, W_TOTAL = W_FF2 + (size_t)1024 * 4096 * 2;
static_assert(W_TOTAL <= 28 * MiB, "weights region");
constexpr size_t MISC_CTL = 0, CTL_BYTES = 65536, MISC_TAB64 = 65536, MISC_TAB32 = MISC_TAB64 + (size_t)LSEQ * 32 * 8, MISC_SSQ = MISC_TAB32 + (size_t)LSEQ * 16 * 8,
                 MISC_END = MISC_SSQ + (size_t)DEPTH * 2 * MROWS * 4;
static_assert(MISC_END <= 4 * MiB, "misc region");
constexpr size_t B_MIX = 0, B_KSB = 99 * MiB, B_VTSB = 132 * MiB, B_RQ = 165 * MiB, B_RK = B_RQ + 33 * MiB / 2, B_RVT = 198 * MiB, B_KN = 231 * MiB, B_U = 0;
constexpr size_t O_VTMLA = 0, O_CQ = 33 * MiB, O_CKV = O_CQ + (size_t)MROWS * 384 * 2, O_QR = O_CKV + (size_t)MROWS * 256 * 2, O_KR = O_QR + (size_t)MROWS * 256 * 2, O_END = O_KR + (size_t)MROWS * 32 * 2;
constexpr size_t O_DT = 93 * MiB, O_RKT = 109 * MiB;
static_assert(O_END <= O_DT && O_RKT + (size_t)MROWS * 256 * 2 <= 128 * MiB, "d_out scratch");

__device__ __forceinline__ unsigned f2bf(float f) { unsigned u = __builtin_bit_cast(unsigned, f); return (u + 0x7fffu + ((u >> 16) & 1u)) >> 16; }
__device__ __forceinline__ unsigned cvtpk(float lo, float hi) { f32x2 v = {lo, hi}; bf16x2_t b = __builtin_convertvector(v, bf16x2_t); return __builtin_bit_cast(unsigned, b); }
__device__ __forceinline__ float bf2f(unsigned short b) { return __builtin_bit_cast(float, (unsigned)b << 16); }
__device__ __forceinline__ float ex2(float x) { return __builtin_amdgcn_exp2f(x); }
__device__ __forceinline__ float wave_sum(float v) {
#pragma unroll
    for (int o = 1; o < 64; o <<= 1) v += __shfl_xor(v, o);
    return v;
}
__device__ __forceinline__ float ret_lg(int h) {
    return h == 0 ? -0.04580368961312479f : h == 1 ? -0.02272007650008353f : h == 2 ? -0.011315313227834146f : -0.005646563141142063f;
}

struct Ptrs {
    const float* in[16]; float* out; unsigned char* ws;
    float* H; bf16* HB; bf16* Win; bf16* Wuq; bf16* Wukv; bf16* Wout; bf16* W1; bf16* W2;
    unsigned* ctl; f32x2* tab64; f32x2* tab32; float* ssq;
    bf16 *MIX, *KSB, *VTSB, *RQ, *RK, *RVT, *KN, *U, *VTMLA, *CQ, *CKV, *QR, *KR, *RKT; float* DT;
};

#define GAS __attribute__((address_space(1)))
__device__ __forceinline__ void fill_ptrs(Ptrs& P, unsigned char* wsl_, float* outl_) {
    unsigned char* wsl = (unsigned char*)(GAS unsigned char*)wsl_; float* outl = (float*)(GAS float*)outl_;
    P.out = outl; P.ws = wsl;
    P.H = (float*)(wsl + WS_H); P.HB = (bf16*)(wsl + WS_HB);
    unsigned char* wb = wsl + WS_W;
    P.Win = (bf16*)(wb + W_IN); P.Wuq = (bf16*)(wb + W_UQ); P.Wukv = (bf16*)(wb + W_UKV); P.Wout = (bf16*)(wb + W_OUT); P.W1 = (bf16*)(wb + W_FF1); P.W2 = (bf16*)(wb + W_FF2);
    unsigned char* mb = wsl + WS_MISC;
    P.ctl = (unsigned*)(mb + MISC_CTL); P.tab64 = (f32x2*)(mb + MISC_TAB64); P.tab32 = (f32x2*)(mb + MISC_TAB32); P.ssq = (float*)(mb + MISC_SSQ);
    unsigned char* bb = wsl + WS_B;
    P.MIX = (bf16*)(bb + B_MIX); P.KSB = (bf16*)(bb + B_KSB); P.VTSB = (bf16*)(bb + B_VTSB); P.RQ = (bf16*)(bb + B_RQ); P.RK = (bf16*)(bb + B_RK); P.RVT = (bf16*)(bb + B_RVT);
    P.KN = (bf16*)(bb + B_KN); P.U = (bf16*)(bb + B_U);
    unsigned char* ob = (unsigned char*)outl;
    P.VTMLA = (bf16*)(ob + O_VTMLA); P.CQ = (bf16*)(ob + O_CQ); P.CKV = (bf16*)(ob + O_CKV); P.QR = (bf16*)(ob + O_QR); P.KR = (bf16*)(ob + O_KR); P.RKT = (bf16*)(ob + O_RKT); P.DT = (float*)(ob + O_DT);
}
#define EPI_PTRS Ptrs P; { size_t z_ = 0; asm volatile("" : "+s"(z_)); fill_ptrs(P, ws_ + z_, out_ + z_); } \
                 float* ssq_q = P.ssq + (size_t)(2 * layer_) * MROWS; float* ssq_kv = ssq_q + MROWS; (void)ssq_q; (void)ssq_kv;
using pg8::Unit;
#define EPI_ROWS_BEGIN  _Pragma("unroll") for (int ai = 0; ai < 2; ++ai) _Pragma("unroll") for (int m = 0; m < 4; ++m) { const int row = u.pm * 256 + ai * 128 + wr * 64 + m * 16 + fr; const int cl = wc * 32 + fq * 4; (void)cl;
#define EPI_ROWS_END    asm volatile("" ::: "memory"); }
#define EPI_COLS_BEGIN  _Pragma("unroll") for (int bj = 0; bj < 2; ++bj) _Pragma("unroll") for (int n = 0; n < 2; ++n) { const int co = bj * 128 + n * 16; const int c = co + cl; (void)c; const f32x4 v = acc[ai][bj][m][n];
#define EPI_COLS_END    }

__device__ __forceinline__ void st_bf4(bf16* p, f32x4 v) { u32x2 w; w.x = cvtpk(v[0], v[1]); w.y = cvtpk(v[2], v[3]); *(u32x2*)p = w; }

struct EpiIn {
    static constexpr bool PERM = false, AFTER_DRAIN = false;
    unsigned char* ws_; float* out_; int layer_;
    __device__ __forceinline__ void plain(const f32x4 (&acc)[2][2][4][2], const Unit& u, int wr, int wc, int fr, int fq, bf16* dst, int ld, int col0) const {
        EPI_ROWS_BEGIN
            bf16* rp = dst + (unsigned)(row * ld + col0 + cl);
            EPI_COLS_BEGIN st_bf4(rp + co, v); EPI_COLS_END
        EPI_ROWS_END
    }
    template <int HD> __device__ __forceinline__ void transposed(const f32x4 (&acc)[2][2][4][2], const Unit& u, int wr, int wc, int fr, int fq, bf16* dst, int cc0) const {
        constexpr int NH = 512 / HD;
        EPI_ROWS_BEGIN
            const int b = row / LSEQ, t = row - b * LSEQ;
            EPI_COLS_BEGIN
                const int cc = cc0 + c, head = cc / HD, d = cc % HD;
                bf16* q = dst + ((size_t)(b * NH + head) * HD + d) * LSEQ + t;
                q[0] = (bf16)f2bf(v[0]); q[LSEQ] = (bf16)f2bf(v[1]); q[2 * LSEQ] = (bf16)f2bf(v[2]); q[3 * LSEQ] = (bf16)f2bf(v[3]);
            EPI_COLS_END
        EPI_ROWS_END
    }
    __device__ __forceinline__ void withssq(const f32x4 (&acc)[2][2][4][2], const Unit& u, int wr, int wc, int fr, int fq, bf16* dst, int ld, int col0, float* ssq, int nbj) const {
        EPI_ROWS_BEGIN
            float s = 0.f; bf16* rp = dst + (unsigned)(row * ld + col0 + cl);
#pragma unroll
            for (int bj = 0; bj < 2; ++bj) if (bj < nbj) {
#pragma unroll
                for (int n = 0; n < 2; ++n) { const f32x4 v = acc[ai][bj][m][n];
                    st_bf4(rp + bj * 128 + n * 16, v); s += (v[0] * v[0] + v[1] * v[1]) + (v[2] * v[2] + v[3] * v[3]); } }
            s += __shfl_xor(s, 16); s += __shfl_xor(s, 32);
            if (fq == 0) atomicAdd(ssq + row, s);
        EPI_ROWS_END
    }
    template <bool ISK> __device__ __forceinline__ void rope64(const Ptrs& P, const f32x4 (&acc)[2][2][4][2], const Unit& u, int wr, int wc, int fr, int fq, bf16* dst) const {
        EPI_ROWS_BEGIN
            const int b = row / LSEQ, t = row - b * LSEQ; const int d0 = 16 * (wc & 1) + 4 * fq;
            const f32x4* tp = (const f32x4*)(P.tab64 + (size_t)t * 32 + d0); const f32x4 cs0 = tp[0], cs1 = tp[1];
#pragma unroll
            for (int bj = 0; bj < 2; ++bj) { const int hd = 2 * bj + (wc >> 1); const f32x4 x1 = acc[ai][bj][m][0], x2 = acc[ai][bj][m][1];
                float f;
                if (ISK) f = (t >= NPAD) ? ex2(-(float)(t & 63) * ret_lg(hd)) : 0.f; else f = ex2((float)(t & 31) * ret_lg(hd));
                f32x4 o1, o2;
                o1[0] = (x1[0] * cs0[0] - x2[0] * cs0[1]) * f; o2[0] = (x1[0] * cs0[1] + x2[0] * cs0[0]) * f;
                o1[1] = (x1[1] * cs0[2] - x2[1] * cs0[3]) * f; o2[1] = (x1[1] * cs0[3] + x2[1] * cs0[2]) * f;
                o1[2] = (x1[2] * cs1[0] - x2[2] * cs1[1]) * f; o2[2] = (x1[2] * cs1[1] + x2[2] * cs1[0]) * f;
                o1[3] = (x1[3] * cs1[2] - x2[3] * cs1[3]) * f; o2[3] = (x1[3] * cs1[3] + x2[3] * cs1[2]) * f;
                bf16* q = dst + (size_t)row * 256 + 64 * hd + d0; st_bf4(q, o1); st_bf4(q + 32, o2);
                if (ISK) { bf16* qt = P.RKT + ((size_t)(b * 4 + hd) * 64 + d0) * LSEQ + t;
#pragma unroll
                    for (int j = 0; j < 4; ++j) { qt[(size_t)j * LSEQ] = (bf16)f2bf(o1[j]); qt[(size_t)(32 + j) * LSEQ] = (bf16)f2bf(o2[j]); } } }
        EPI_ROWS_END
    }
    __device__ __forceinline__ void operator()(const f32x4 (&acc)[2][2][4][2], const Unit& u, int wr, int wc, int fr, int fq) const {
        const int pn = u.pn; EPI_PTRS
        if (pn < 2) plain(acc, u, wr, wc, fr, fq, P.MIX, DMIX, pn * 256);
        else if (pn < 4) plain(acc, u, wr, wc, fr, fq, P.KSB, 512, (pn - 2) * 256);
        else if (pn < 6) transposed<64>(acc, u, wr, wc, fr, fq, P.VTSB, (pn - 4) * 256);
        else if (pn == 6) rope64<false>(P, acc, u, wr, wc, fr, fq, P.RQ);
        else if (pn == 7) rope64<true>(P, acc, u, wr, wc, fr, fq, P.RK);
        else if (pn < 10) transposed<128>(acc, u, wr, wc, fr, fq, P.RVT, (pn - 8) * 256);
        else if (pn < 12) plain(acc, u, wr, wc, fr, fq, P.MIX, DMIX, 1024 + (pn - 10) * 256);
        else if (pn == 12) withssq(acc, u, wr, wc, fr, fq, P.CKV, 256, 0, ssq_kv, 2);
        else if (pn == 13) withssq(acc, u, wr, wc, fr, fq, P.CQ, 384, 0, ssq_q, 2);
        else {
            withssq(acc, u, wr, wc, fr, fq, P.CQ, 384, 256, ssq_q, 1);
            if (wc == 0) {
                EPI_ROWS_BEGIN
                    const int b = row / LSEQ, t = row - b * LSEQ;
                    const f32x4* tp = (const f32x4*)(P.tab32 + (size_t)t * 16 + 4 * fq); const f32x4 cs0 = tp[0], cs1 = tp[1];
                    const f32x4 x1 = acc[ai][1][m][0], x2 = acc[ai][1][m][1]; f32x4 o1, o2;
                    o1[0] = x1[0] * cs0[0] - x2[0] * cs0[1]; o2[0] = x1[0] * cs0[1] + x2[0] * cs0[0];
                    o1[1] = x1[1] * cs0[2] - x2[1] * cs0[3]; o2[1] = x1[1] * cs0[3] + x2[1] * cs0[2];
                    o1[2] = x1[2] * cs1[0] - x2[2] * cs1[1]; o2[2] = x1[2] * cs1[1] + x2[2] * cs1[0];
                    o1[3] = x1[3] * cs1[2] - x2[3] * cs1[3]; o2[3] = x1[3] * cs1[3] + x2[3] * cs1[2];
                    bf16* q = P.KR + (size_t)row * 32 + 4 * fq; st_bf4(q, o1); st_bf4(q + 16, o2);
                EPI_ROWS_END
            }
        }
    }
};

struct EpiUq {
    static constexpr bool PERM = false, AFTER_DRAIN = false;
    unsigned char* ws_; float* out_; int layer_;
    __device__ __forceinline__ void operator()(const f32x4 (&acc)[2][2][4][2], const Unit& u, int wr, int wc, int fr, int fq) const {
        const int pn = u.pn; EPI_PTRS
        if (pn < 2) {
            EPI_ROWS_BEGIN
                const float ri = 1.0f / sqrtf(ssq_q[row] * (1.0f / 384.0f) + LN_EPS);
                bf16* rp = P.MIX + (unsigned)(row * DMIX + 512 + pn * 256 + cl);
                EPI_COLS_BEGIN st_bf4(rp + co, v * ri); EPI_COLS_END
            EPI_ROWS_END
        } else {
            EPI_ROWS_BEGIN
                const float ri = 1.0f / sqrtf(ssq_q[row] * (1.0f / 384.0f) + LN_EPS);
                const int b = row / LSEQ, t = row - b * LSEQ;
                const f32x4* tp = (const f32x4*)(P.tab32 + (size_t)t * 16 + 4 * fq); const f32x4 cs0 = tp[0], cs1 = tp[1];
#pragma unroll
                for (int bj = 0; bj < 2; ++bj) { const int head = 4 * bj + wc; const f32x4 x1 = acc[ai][bj][m][0] * ri, x2 = acc[ai][bj][m][1] * ri; f32x4 o1, o2;
                    o1[0] = x1[0] * cs0[0] - x2[0] * cs0[1]; o2[0] = x1[0] * cs0[1] + x2[0] * cs0[0];
                    o1[1] = x1[1] * cs0[2] - x2[1] * cs0[3]; o2[1] = x1[1] * cs0[3] + x2[1] * cs0[2];
                    o1[2] = x1[2] * cs1[0] - x2[2] * cs1[1]; o2[2] = x1[2] * cs1[1] + x2[2] * cs1[0];
                    o1[3] = x1[3] * cs1[2] - x2[3] * cs1[3]; o2[3] = x1[3] * cs1[3] + x2[3] * cs1[2];
                    bf16* q = P.QR + (size_t)row * 256 + 32 * head + 4 * fq; st_bf4(q, o1); st_bf4(q + 16, o2); }
            EPI_ROWS_END
        }
    }
};

struct EpiUkv {
    static constexpr bool PERM = false, AFTER_DRAIN = false;
    unsigned char* ws_; float* out_; int layer_;
    __device__ __forceinline__ void operator()(const f32x4 (&acc)[2][2][4][2], const Unit& u, int wr, int wc, int fr, int fq) const {
        const int pn = u.pn; EPI_PTRS
        if (pn < 2) {
            EPI_ROWS_BEGIN
                const float ri = 1.0f / sqrtf(ssq_kv[row] * (1.0f / 256.0f) + LN_EPS);
                bf16* rp = P.KN + (unsigned)(row * 512 + pn * 256 + cl);
                EPI_COLS_BEGIN st_bf4(rp + co, v * ri); EPI_COLS_END
            EPI_ROWS_END
        } else {
            EPI_ROWS_BEGIN
                const float ri = 1.0f / sqrtf(ssq_kv[row] * (1.0f / 256.0f) + LN_EPS);
                const int b = row / LSEQ, t = row - b * LSEQ;
                EPI_COLS_BEGIN
                    const int cc = (pn - 2) * 256 + c, head = cc >> 6, d = cc & 63;
                    bf16* q = P.VTMLA + ((size_t)(b * 8 + head) * 64 + d) * LSEQ + t;
                    q[0] = (bf16)f2bf(v[0] * ri); q[LSEQ] = (bf16)f2bf(v[1] * ri); q[2 * LSEQ] = (bf16)f2bf(v[2] * ri); q[3 * LSEQ] = (bf16)f2bf(v[3] * ri);
                EPI_COLS_END
            EPI_ROWS_END
        }
    }
};

struct EpiRes {
    static constexpr bool PERM = true, AFTER_DRAIN = false;
    float* H;
    __device__ __forceinline__ void operator()(const f32x4 (&acc)[2][2][4][2], const Unit& u, int wr, int wc, int fr, int fq) const {
        EPI_ROWS_BEGIN
            float* rp = H + (unsigned)(row * DM + u.pn * 256 + wc * 32 + fq * 8);
#pragma unroll
            for (int bj = 0; bj < 2; ++bj) { f32x4* q = (f32x4*)(rp + bj * 128); const f32x4 h0 = q[0], h1 = q[1];
                q[0] = h0 * DN_ALPHA + acc[ai][bj][m][0]; q[1] = h1 * DN_ALPHA + acc[ai][bj][m][1]; }
        EPI_ROWS_END
    }
};

struct EpiFf1 {
    static constexpr bool PERM = true, AFTER_DRAIN = false;
    bf16* U;
    __device__ __forceinline__ void operator()(const f32x4 (&acc)[2][2][4][2], const Unit& u, int wr, int wc, int fr, int fq) const {
        EPI_ROWS_BEGIN
            bf16* rp = U + (unsigned)(row * DFF + u.pn * 256 + wc * 32 + fq * 8);
#pragma unroll
            for (int bj = 0; bj < 2; ++bj) { f32x4 a0 = acc[ai][bj][m][0], a1 = acc[ai][bj][m][1];
#pragma unroll
                for (int j = 0; j < 4; ++j) { a0[j] = fmaxf(a0[j], 0.f); a1[j] = fmaxf(a1[j], 0.f); }
                a0 = a0 * a0; a1 = a1 * a1;
                *(u32x4*)(rp + bj * 128) = (u32x4){cvtpk(a0[0], a0[1]), cvtpk(a0[2], a0[3]), cvtpk(a1[0], a1[1]), cvtpk(a1[2], a1[3])}; }
        EPI_ROWS_END
    }
};

constexpr int TAIL_PM0 = 128, TAIL_ROW0 = TAIL_PM0 * 256, NSPLIT = 4;
struct EpiPart {
    static constexpr bool PERM = true, AFTER_DRAIN = false;
    float* PART; int ktper;
    __device__ __forceinline__ void operator()(const f32x4 (&acc)[2][2][4][2], const Unit& u, int wr, int wc, int fr, int fq) const {
        float* slab = PART + (size_t)(u.kt0 / ktper) * (1024 * 1024);
        EPI_ROWS_BEGIN
            float* rp = slab + (unsigned)((row - TAIL_ROW0) * DM + u.pn * 256 + wc * 32 + fq * 8);
#pragma unroll
            for (int bj = 0; bj < 2; ++bj) { f32x4* q = (f32x4*)(rp + bj * 128); q[0] = acc[ai][bj][m][0]; q[1] = acc[ai][bj][m][1]; }
        EPI_ROWS_END
    }
};
struct TailOrder {
    int G, c, ktper;
    __device__ bool next(int i, Unit& u) const { const int Lx = i * G + c; if (Lx >= 16 * NSPLIT) return false; const int tile = Lx / NSPLIT, ks = Lx % NSPLIT;
        u.pm = TAIL_PM0 + (tile >> 2); u.pn = tile & 3; u.kt0 = ks * ktper; return true; }
    __device__ __forceinline__ void a_ready(const Unit&) const {}
    __device__ __forceinline__ void done(const Unit&) const {}
};

namespace att {
constexpr int KBUF = 64 * 208, VBUF = 128 * 144, OFF_K = 0, OFF_V = 2 * KBUF, OFF_WS = OFF_V + 2 * VBUF, OFF_UNIT = OFF_WS + 8 * 256, OFF_ST = OFF_UNIT + 256, STROW = 144;
__device__ __forceinline__ int crow(int r, int hi) { return (r & 3) + 8 * (r >> 2) + 4 * hi; }
#define MFMA32(a, b, c) __builtin_amdgcn_mfma_f32_32x32x16_bf16((a), (b), (c), 0, 0, 0)


__device__ __forceinline__ void pack4(const f32x16& p0, const f32x16& p1, u32x4 (&pf)[4]) {
    pf[0] = (u32x4){cvtpk(p0[0], p0[1]), cvtpk(p0[2], p0[3]), cvtpk(p0[4], p0[5]), cvtpk(p0[6], p0[7])};
    pf[1] = (u32x4){cvtpk(p0[8], p0[9]), cvtpk(p0[10], p0[11]), cvtpk(p0[12], p0[13]), cvtpk(p0[14], p0[15])};
    pf[2] = (u32x4){cvtpk(p1[0], p1[1]), cvtpk(p1[2], p1[3]), cvtpk(p1[4], p1[5]), cvtpk(p1[6], p1[7])};
    pf[3] = (u32x4){cvtpk(p1[8], p1[9]), cvtpk(p1[10], p1[11]), cvtpk(p1[12], p1[13]), cvtpk(p1[14], p1[15])};
}
template <bool MASK>
__device__ __forceinline__ void sb_sub(const f32x16& p, int keybase, int tq, int hi, float& carry, u32x4& f0, u32x4& f1) {
    float kp[16], sg[16];
#pragma unroll
    for (int r = 0; r < 16; ++r) {
        const float e = ex2(p[r]); float kk = __builtin_amdgcn_rcpf(1.0f + e); float s_ = 1.0f - kk;
        if (MASK) { const int key = keybase + crow(r, hi); const bool ok = (key < tq) && (key >= NPAD); kk = ok ? kk : 1.0f; s_ = ok ? s_ : 0.f; }
        kp[r] = kk; sg[r] = s_;
    }
    float G[4], Gp[4], GG[4];
#pragma unroll
    for (int q = 0; q < 4; ++q) { G[q] = (kp[4 * q] * kp[4 * q + 1]) * (kp[4 * q + 2] * kp[4 * q + 3]);
        const auto rr = __builtin_amdgcn_permlane32_swap(__float_as_uint(G[q]), __float_as_uint(G[q]), false, false);
        Gp[q] = __uint_as_float(rr[1]); GG[q] = __uint_as_float(rr[0]) * __uint_as_float(rr[1]); }
    float T[4]; T[3] = 1.0f; T[2] = GG[3]; T[1] = GG[3] * GG[2]; T[0] = T[1] * GG[1];
    float w[16];
#pragma unroll
    for (int q = 0; q < 4; ++q) {
        const float base = carry * T[q] * (hi == 0 ? Gp[q] : 1.0f);
        const float e3 = base, e2 = e3 * kp[4 * q + 3], e1 = e2 * kp[4 * q + 2], e0 = e1 * kp[4 * q + 1];
        w[4 * q + 3] = sg[4 * q + 3] * e3; w[4 * q + 2] = sg[4 * q + 2] * e2; w[4 * q + 1] = sg[4 * q + 1] * e1; w[4 * q] = sg[4 * q] * e0;
    }
    carry *= T[0] * GG[0];
    f0 = (u32x4){cvtpk(w[0], w[1]), cvtpk(w[2], w[3]), cvtpk(w[4], w[5]), cvtpk(w[6], w[7])};
    f1 = (u32x4){cvtpk(w[8], w[9]), cvtpk(w[10], w[11]), cvtpk(w[12], w[13]), cvtpk(w[14], w[15])};
}
template <int KIND>
__device__ __forceinline__ void unit(const Ptrs& P, int bh, int u, LAS unsigned char* lds, bool do_store) {
    constexpr int DQK = (KIND == 1) ? 96 : 64, DV = (KIND == 2) ? 128 : 64, NH = (KIND == 2) ? 4 : 8, KROW = DQK * 2 + 16, VROW = 144, NQF = DQK / 16, NDB = DV / 32;
    int tid_l = threadIdx.x; asm volatile("" : "+v"(tid_l));
    const int tid = tid_l, lane = tid & 63, r32 = lane & 31, hi = lane >> 5, wid = __builtin_amdgcn_readfirstlane(tid >> 6);
    const int b = bh / NH, h = bh % NH;
    const int q0 = (u == 0) ? 0 : 128 + 256 * (u - 1), nrows = (u == 0) ? 128 : 256, ktmax = (u == 0) ? 1 : 4 * u + 1;
    const size_t rowb = (size_t)b * LSEQ;
    const bool active = (32 * wid < nrows);
    const int q0w = q0 + 32 * wid, tq = q0w + r32, ktw = (q0w + 31) >> 6;
    const bf16* Qb; int ldq; const bf16* Kb; int ldk; const bf16* VT;
    if (KIND == 0) { Qb = P.MIX + h * 64; ldq = DMIX; Kb = P.KSB + h * 64; ldk = 512; VT = P.VTSB; }
    else if (KIND == 1) { Qb = P.MIX + 512 + h * 64; ldq = DMIX; Kb = P.KN + h * 64; ldk = 512; VT = P.VTMLA; }
    else { Qb = P.RQ + h * 64; ldq = 256; Kb = P.RK + h * 64; ldk = 256; VT = P.RVT; }
    VT += (size_t)bh * DV * LSEQ;
    bf16x8 qf[NQF];
#pragma unroll
    for (int d0 = 0; d0 < NQF; ++d0) qf[d0] = (bf16x8){0, 0, 0, 0, 0, 0, 0, 0};
    if (active) {
#pragma unroll
        for (int d0 = 0; d0 < 4; ++d0) qf[d0] = *(const bf16x8*)(Qb + (rowb + tq) * ldq + 16 * d0 + 8 * hi);
        if (KIND == 1) {
#pragma unroll
            for (int d0 = 0; d0 < 2; ++d0) qf[(KIND == 1) ? 4 + d0 : 0] = *(const bf16x8*)(P.QR + (rowb + tq) * 256 + h * 32 + 16 * d0 + 8 * hi);
        }
    }
    f32x16 o[NDB];
#pragma unroll
    for (int d = 0; d < NDB; ++d) o[d] = (f32x16){0.f, 0.f, 0.f, 0.f, 0.f, 0.f, 0.f, 0.f, 0.f, 0.f, 0.f, 0.f, 0.f, 0.f, 0.f, 0.f};
    float carry = 1.0f, mrun = -1e30f, lrun = 0.f;
    LAS float* wsf = (LAS float*)(lds + OFF_WS) + wid * 64;
    u32x4 kreg, kreg2 = (u32x4){0u, 0u, 0u, 0u}, vreg[DV / 64];
    const int srow = tid >> 3, sch = tid & 7;
#define ATT_LOAD(kt_) do { const size_t key0_ = rowb + (size_t)64 * (kt_); \
        kreg = *(const u32x4*)(Kb + (key0_ + srow) * ldk + sch * 8); \
        if (KIND == 1 && tid < 256) kreg2 = *(const u32x4*)(P.KR + (key0_ + (tid >> 2)) * 32 + (tid & 3) * 8); \
        _Pragma("unroll") for (int i_ = 0; i_ < DV / 64; ++i_) vreg[i_] = *(const u32x4*)(VT + (size_t)(srow + 64 * i_) * LSEQ + 64 * (kt_) + sch * 8); } while (0)
#define ATT_WRITE(buf_) do { LAS unsigned char* kb_ = lds + OFF_K + (buf_) * KBUF; LAS unsigned char* vb_ = lds + OFF_V + (buf_) * VBUF; \
        *(LAS u32x4*)(kb_ + srow * KROW + sch * 16) = kreg; \
        if (KIND == 1 && tid < 256) *(LAS u32x4*)(kb_ + (tid >> 2) * KROW + 128 + (tid & 3) * 16) = kreg2; \
        _Pragma("unroll") for (int i_ = 0; i_ < DV / 64; ++i_) { LAS unsigned char* q_ = vb_ + (srow + 64 * i_) * VROW + (sch >> 1) * 32 + (sch & 1) * 8; \
            *(LAS u32x2*)q_ = (u32x2){vreg[i_].x, vreg[i_].y}; *(LAS u32x2*)(q_ + 16) = (u32x2){vreg[i_].z, vreg[i_].w}; } } while (0)

    int ktmin = 1;
    if (KIND == 2 && u >= 1) {
        ktmin = q0 >> 6;
        const float g256 = ex2(256.0f * ret_lg(h));
        const int e_ = tid >> 2, dseg = (tid & 3) * 16;
        const float* dp = P.DT + ((size_t)bh * 16 * 128 + e_) * 64 + dseg;
        f32x4 sacc[4];
#pragma unroll
        for (int c_ = 0; c_ < 4; ++c_) sacc[c_] = (f32x4){0.f, 0.f, 0.f, 0.f};
        int blk = 0;
        for (; blk + 4 <= u; blk += 4) {
            f32x4 ld_[4][4];
#pragma unroll
            for (int i_ = 0; i_ < 4; ++i_)
#pragma unroll
                for (int c_ = 0; c_ < 4; ++c_) ld_[i_][c_] = *(const f32x4*)(dp + (size_t)(blk + i_) * 128 * 64 + 4 * c_);
#pragma unroll
            for (int i_ = 0; i_ < 4; ++i_)
#pragma unroll
                for (int c_ = 0; c_ < 4; ++c_) sacc[c_] = sacc[c_] * g256 + ld_[i_][c_];
        }
        for (; blk < u; ++blk) {
#pragma unroll
            for (int c_ = 0; c_ < 4; ++c_) sacc[c_] = sacc[c_] * g256 + *(const f32x4*)(dp + (size_t)blk * 128 * 64 + 4 * c_);
        }
        LAS unsigned char* stp = lds + OFF_ST + e_ * STROW + dseg * 2;
        *(LAS u32x4*)stp = (u32x4){cvtpk(sacc[0][0], sacc[0][1]), cvtpk(sacc[0][2], sacc[0][3]), cvtpk(sacc[1][0], sacc[1][1]), cvtpk(sacc[1][2], sacc[1][3])};
        *(LAS u32x4*)(stp + 16) = (u32x4){cvtpk(sacc[2][0], sacc[2][1]), cvtpk(sacc[2][2], sacc[2][3]), cvtpk(sacc[3][0], sacc[3][1]), cvtpk(sacc[3][2], sacc[3][3])};
        __syncthreads();
        if (active) {
#pragma unroll
            for (int s_ = 0; s_ < 4; ++s_)
#pragma unroll
                for (int d = 0; d < NDB; ++d) {
                    const bf16x8 sf = *(const LAS bf16x8*)(lds + OFF_ST + (32 * d + r32) * STROW + (16 * s_ + 8 * hi) * 2);
                    o[d] = MFMA32(qf[s_], sf, o[d]);
                }
            const float gw_ = ex2((float)(32 * wid) * ret_lg(h));
#pragma unroll
            for (int d = 0; d < NDB; ++d)
#pragma unroll
                for (int r = 0; r < 16; ++r) o[d][r] *= gw_;
        }
    }
    int buf = 0;
    ATT_LOAD(ktmax); ATT_WRITE(0);
    __syncthreads();
    for (int kt = ktmax; kt >= ktmin; --kt) {
        if (kt > ktmin) ATT_LOAD(kt - 1);
        if (active && kt <= ktw) {
            const LAS unsigned char* Kt = lds + OFF_K + buf * KBUF; const LAS unsigned char* Vt = lds + OFF_V + buf * VBUF;
            f32x16 p0 = (f32x16){0.f, 0.f, 0.f, 0.f, 0.f, 0.f, 0.f, 0.f, 0.f, 0.f, 0.f, 0.f, 0.f, 0.f, 0.f, 0.f}, p1 = p0;
            {
                bf16x8 kfa[NQF], kfb[NQF];
#pragma unroll
                for (int d0 = 0; d0 < NQF; ++d0) { kfa[d0] = *(const LAS bf16x8*)(Kt + r32 * KROW + (16 * d0 + 8 * hi) * 2); kfb[d0] = *(const LAS bf16x8*)(Kt + (32 + r32) * KROW + (16 * d0 + 8 * hi) * 2); }
#pragma unroll
                for (int d0 = 0; d0 < NQF; ++d0) { p0 = MFMA32(kfa[d0], qf[d0], p0); p1 = MFMA32(kfb[d0], qf[d0], p1); }
            }
            bf16x8 vfr[(NDB == 2) ? 8 : 1];
            if (NDB == 2) {
#pragma unroll
                for (int ks = 0; ks < 4; ++ks)
#pragma unroll
                    for (int d = 0; d < 2; ++d) vfr[(NDB == 2) ? 2 * ks + d : 0] = *(const LAS bf16x8*)(Vt + (32 * d + r32) * VROW + (16 * ks + 8 * hi) * 2);
            }
            const int k0key = 64 * kt;
            const bool needmask = (k0key + 63 >= q0w) || (kt == 1);
            u32x4 pf[4];
            if (KIND == 0) {
                if (needmask) { sb_sub<true>(p1, k0key + 32, tq, hi, carry, pf[2], pf[3]); sb_sub<true>(p0, k0key, tq, hi, carry, pf[0], pf[1]); }
                else { sb_sub<false>(p1, k0key + 32, tq, hi, carry, pf[2], pf[3]); sb_sub<false>(p0, k0key, tq, hi, carry, pf[0], pf[1]); }
            } else if (KIND == 1) {
                if (needmask) {
#pragma unroll
                    for (int r = 0; r < 16; ++r) { const int key = k0key + crow(r, hi);
                        if (!((key <= tq) && (key >= NPAD))) p0[r] = -1e30f;
                        if (!((key + 32 <= tq) && (key + 32 >= NPAD))) p1[r] = -1e30f; }
                    asm volatile("" : "+v"(p0), "+v"(p1));
                }
                float mx = fmaxf(p0[0], p1[0]);
#pragma unroll
                for (int r = 1; r < 16; ++r) mx = fmaxf(mx, fmaxf(p0[r], p1[r]));
                { const auto rr = __builtin_amdgcn_permlane32_swap(__float_as_uint(mx), __float_as_uint(mx), false, false); mx = fmaxf(__uint_as_float(rr[0]), __uint_as_float(rr[1])); }
                const float mnew = fmaxf(mrun, mx);
                if (__any(mnew > mrun)) {
                    const float alpha = ex2(mrun - mnew); lrun *= alpha;
                    if (hi == 0) wsf[r32] = alpha;
                    asm volatile("s_waitcnt lgkmcnt(0)" ::: "memory");
#pragma unroll
                    for (int r = 0; r < 16; ++r) { const float a = wsf[crow(r, hi)];
#pragma unroll
                        for (int d = 0; d < NDB; ++d) o[d][r] *= a; }
                    asm volatile("s_waitcnt lgkmcnt(0)" ::: "memory");
                }
                mrun = mnew;
                float ls = 0.f;
#pragma unroll
                for (int r = 0; r < 16; ++r) { p0[r] = ex2(p0[r] - mrun); p1[r] = ex2(p1[r] - mrun); ls += p0[r] + p1[r]; }
                lrun += ls;
                pack4(p0, p1, pf);
            } else {
                const float cdec = ex2((float)(q0w - k0key) * ret_lg(h));
#pragma unroll
                for (int r = 0; r < 16; ++r) { p0[r] *= cdec; p1[r] *= cdec; }
                if (needmask) {
#pragma unroll
                    for (int r = 0; r < 16; ++r) { const int key = k0key + crow(r, hi); if (key > tq) p0[r] = 0.f; if (key + 32 > tq) p1[r] = 0.f; }
                    asm volatile("" : "+v"(p0), "+v"(p1));
                }
                pack4(p0, p1, pf);
            }
#pragma unroll
            for (int ks = 0; ks < 4; ++ks) {
                const bf16x8 pa = __builtin_bit_cast(bf16x8, pf[ks]);
#pragma unroll
                for (int d = 0; d < NDB; ++d) {
                    const bf16x8 vf = (NDB == 2) ? vfr[(NDB == 2) ? 2 * ks + d : 0] : *(const LAS bf16x8*)(Vt + (32 * d + r32) * VROW + (16 * ks + 8 * hi) * 2);
                    o[d] = MFMA32(pa, vf, o[d]);
                }
            }
        }
        if (kt > ktmin) ATT_WRITE(buf ^ 1);
        __syncthreads();
        buf ^= 1;
    }
#undef ATT_LOAD
#undef ATT_WRITE
    if (active && do_store) {
        if (KIND == 0) {
#pragma unroll
            for (int r = 0; r < 16; ++r) { bf16* q = P.MIX + (rowb + q0w + crow(r, hi)) * DMIX + h * 64 + r32;
#pragma unroll
                for (int d = 0; d < NDB; ++d) q[32 * d] = (bf16)f2bf(o[d][r]); }
        } else if (KIND == 1) {
            const float lt = lrun + __shfl_xor(lrun, 32);
            if (hi == 0) wsf[r32] = lt;
            asm volatile("s_waitcnt lgkmcnt(0)" ::: "memory");
#pragma unroll
            for (int r = 0; r < 16; ++r) { const float l_ = wsf[crow(r, hi)]; const float inv = l_ > 0.f ? 1.0f / l_ : 0.f;
                bf16* q = P.MIX + (rowb + q0w + crow(r, hi)) * DMIX + 512 + h * 64 + r32;
#pragma unroll
                for (int d = 0; d < NDB; ++d) q[32 * d] = (bf16)f2bf(o[d][r] * inv); }
            asm volatile("s_waitcnt lgkmcnt(0)" ::: "memory");
        } else {
#pragma unroll
            for (int r = 0; r < 16; ++r) {
                float s = 0.f;
#pragma unroll
                for (int d = 0; d < NDB; ++d) s += o[d][r];
#pragma unroll
                for (int x = 1; x < 32; x <<= 1) s += __shfl_xor(s, x);
                const float mean = s * (1.0f / 128.0f); float q2 = 0.f;
#pragma unroll
                for (int d = 0; d < NDB; ++d) { const float dd = o[d][r] - mean; q2 += dd * dd; }
#pragma unroll
                for (int x = 1; x < 32; x <<= 1) q2 += __shfl_xor(q2, x);
                const float rstd = 1.0f / sqrtf(q2 * (1.0f / 128.0f) + LN_EPS);
                bf16* q = P.MIX + (rowb + q0w + crow(r, hi)) * DMIX + 1024 + h * 128 + r32;
#pragma unroll
                for (int d = 0; d < NDB; ++d) { const float g = bf2f(q[32 * d]); const float sl = g / (1.0f + ex2(-g * 1.4426950408889634f));
                    q[32 * d] = (bf16)f2bf(sl * (o[d][r] - mean) * rstd); }
            }
        }
    }
}
__device__ __forceinline__ void ret_state_jobs(const Ptrs& P) {
    int tid_l = threadIdx.x; asm volatile("" : "+v"(tid_l));
    const int lane = tid_l & 63, r32 = lane & 31, hi = lane >> 5, wid = __builtin_amdgcn_readfirstlane(tid_l >> 6), eb = wid >> 1, db = wid & 1;
    for (int job = blockIdx.x; job < 32 * 16; job += gridDim.x) {
        const int bh = job >> 4, blk = job & 15, h = bh & 3;
        const int key0 = blk == 0 ? 0 : 128 + 256 * (blk - 1), ntile = blk == 0 ? 2 : 4;
        const float g64 = ex2(64.0f * ret_lg(h));
        const bf16* va = P.RVT + ((size_t)bh * 128 + 32 * eb + r32) * LSEQ + key0 + 8 * hi;
        const bf16* kb = P.RKT + ((size_t)bh * 64 + 32 * db + r32) * LSEQ + key0 + 8 * hi;
        f32x16 acc = (f32x16){0.f, 0.f, 0.f, 0.f, 0.f, 0.f, 0.f, 0.f, 0.f, 0.f, 0.f, 0.f, 0.f, 0.f, 0.f, 0.f};
        for (int j = 0; j < ntile; ++j) {
            bf16x8 af[4], bfr[4];
#pragma unroll
            for (int s_ = 0; s_ < 4; ++s_) { af[s_] = *(const bf16x8*)(va + 64 * j + 16 * s_); bfr[s_] = *(const bf16x8*)(kb + 64 * j + 16 * s_); }
#pragma unroll
            for (int s_ = 0; s_ < 4; ++s_) acc = MFMA32(af[s_], bfr[s_], acc);
#pragma unroll
            for (int r = 0; r < 16; ++r) acc[r] *= g64;
        }
        float* dst = P.DT + ((size_t)job * 128 + 32 * eb) * 64 + 32 * db + r32;
#pragma unroll
        for (int r = 0; r < 16; ++r) dst[crow(r, hi) * 64] = acc[r];
    }
}
constexpr int UNITS_PER_LEVEL = 64 + 64 + 32, NUNITS = 17 * UNITS_PER_LEVEL;
__device__ __forceinline__ void phase(const Ptrs& P, LAS unsigned char* lds, unsigned* counter, bool do_store) {
    volatile LAS int* ubox = (volatile LAS int*)(lds + OFF_UNIT);
    for (;;) {
        if (threadIdx.x == 0) ubox[0] = (int)atomicAdd(counter, 1u);
        __syncthreads();
        const int i = __builtin_amdgcn_readfirstlane(ubox[0]);
        __syncthreads();
        if (i >= NUNITS) break;
        const int lvl = i / UNITS_PER_LEVEL, j = i % UNITS_PER_LEVEL, u = 16 - lvl;
        if (j < 64) unit<1>(P, j, u, lds, do_store);
        else if (j < 128) unit<0>(P, j - 64, u, lds, do_store);
        else unit<2>(P, j - 128, u, lds, do_store);
    }
}
}

template <int MODE>
__device__ __forceinline__ void colmap(int p, int& src, float& sc) {
    sc = 1.f; src = p;
    if (MODE == 1) {
        if (p < 1536) { if (p < 512) sc = 0.18033688011112042f; }
        else if (p < 2048) { const int c = (p - 1536) & 255, isk = (p >= 1792), bj = c >> 7, wc = (c >> 5) & 3, n = (c >> 4) & 1, i = c & 15;
            src = (isk ? 2464 : 2208) + 64 * (2 * bj + (wc >> 1)) + 32 * n + 16 * (wc & 1) + i; if (isk) sc = 0.125f; }
        else if (p < 2560) src = 2720 + (p - 2048);
        else if (p < 3072) src = 3232 + (p - 2560);
        else if (p < 3328) src = 1920 + (p - 3072);
        else if (p < 3712) src = 1536 + (p - 3328);
        else if (p < 3744) src = 2176 + (p - 3712);
        else src = -1;
    } else if (MODE == 2) {
        sc = 0.14724444602590306f;
        if (p < 512) src = (p >> 6) * 96 + (p & 63); else { const int q = p - 512; src = (q >> 5) * 96 + 64 + (q & 31); }
    } else if (MODE == 3) {
        if (p < 512) src = (p >> 6) * 128 + (p & 63); else { const int q = p - 512; src = (q >> 6) * 128 + 64 + (q & 63); }
    }
}
template <int MODE>
__device__ __forceinline__ void conv_item(const float* W, int K, int Nsrc, int Nphys, const float* gain, bf16* WT, LAS float* scr, int item, int lane) {
    const int nblk = Nphys / 32, kb = item / nblk, nb = item % nblk, k0 = 64 * kb, n0 = 32 * nb;
    int src; float sc; colmap<MODE>(n0 + (lane & 31), src, sc);
#pragma unroll 8
    for (int i = 0; i < 32; ++i) { const int kk = 2 * i + (lane >> 5); float v = 0.f;
        if (src >= 0) { v = W[(size_t)(k0 + kk) * Nsrc + src] * sc; if (gain) v *= gain[k0 + kk]; }
        scr[kk * 33 + (lane & 31)] = v; }
    asm volatile("s_waitcnt lgkmcnt(0)" ::: "memory");
    const int c = lane & 7;
#pragma unroll
    for (int j = 0; j < 4; ++j) { const int n = (lane >> 3) + 8 * j; const LAS float* s = scr + (8 * c) * 33 + n;
        u32x4 o; o.x = cvtpk(s[0 * 33], s[1 * 33]); o.y = cvtpk(s[2 * 33], s[3 * 33]); o.z = cvtpk(s[4 * 33], s[5 * 33]); o.w = cvtpk(s[6 * 33], s[7 * 33]);
        *(u32x4*)(WT + (size_t)(n0 + n) * K + k0 + 8 * c) = o; }
    asm volatile("s_waitcnt lgkmcnt(0)" ::: "memory");
}
__device__ __forceinline__ void convert_weights(const Ptrs& P, int layer, LAS unsigned char* lds, int gw, int NGW, int wave, int lane) {
    LAS float* scr = (LAS float*)(lds + wave * 16384);
    constexpr int I_IN = 16 * (NIN / 32), I_UQ = 6 * 24, I_UKV = 4 * 32, I_OUT = 24 * 32, I_1 = 16 * 128, I_2 = 64 * 32, NIT = I_IN + I_UQ + I_UKV + I_OUT + I_1 + I_2;
    const float* w_in = P.in[4] + (size_t)layer * 1024 * NIN_LOG; const float* gq = P.in[5] + layer * 384; const float* gkv = P.in[6] + layer * 256;
    const float* w_uq = P.in[7] + (size_t)layer * 384 * 768; const float* w_ukv = P.in[8] + (size_t)layer * 256 * 1024; const float* w_out = P.in[9] + (size_t)layer * 1536 * 1024;
    const float* w1 = P.in[12] + (size_t)layer * 1024 * 4096; const float* w2 = P.in[13] + (size_t)layer * 4096 * 1024;
    for (int it = gw; it < NIT; it += NGW) {
        int r = it;
        if (r < I_IN) { conv_item<1>(w_in, 1024, NIN_LOG, NIN, nullptr, P.Win, scr, r, lane); continue; } r -= I_IN;
        if (r < I_UQ) { conv_item<2>(w_uq, 384, 768, 768, gq, P.Wuq, scr, r, lane); continue; } r -= I_UQ;
        if (r < I_UKV) { conv_item<3>(w_ukv, 256, 1024, 1024, gkv, P.Wukv, scr, r, lane); continue; } r -= I_UKV;
        if (r < I_OUT) { conv_item<0>(w_out, 1536, 1024, 1024, nullptr, P.Wout, scr, r, lane); continue; } r -= I_OUT;
        if (r < I_1) { conv_item<0>(w1, 1024, 4096, 4096, nullptr, P.W1, scr, r, lane); continue; } r -= I_1;
        conv_item<0>(w2, 4096, 1024, 1024, nullptr, P.W2, scr, r, lane);
    }
}
__device__ __forceinline__ void ln_regs(f32x4 (&v)[4], const float* g, const float* bta, int lane) {
    float s = 0.f;
#pragma unroll
    for (int j = 0; j < 4; ++j) s += (v[j][0] + v[j][1]) + (v[j][2] + v[j][3]);
    const float mean = wave_sum(s) * (1.f / DM); float s2 = 0.f;
#pragma unroll
    for (int j = 0; j < 4; ++j) { v[j] = v[j] - mean; s2 += (v[j][0] * v[j][0] + v[j][1] * v[j][1]) + (v[j][2] * v[j][2] + v[j][3] * v[j][3]); }
    const float rstd = 1.f / sqrtf(wave_sum(s2) * (1.f / DM) + LN_EPS);
#pragma unroll
    for (int j = 0; j < 4; ++j) { const f32x4 gg = ((const f32x4*)g)[64 * j + lane], bb = ((const f32x4*)bta)[64 * j + lane]; v[j] = v[j] * rstd * gg + bb; }
}
__device__ __forceinline__ void store_h_hb(const Ptrs& P, int row, const f32x4 (&v)[4], int lane, bool write_h) {
#pragma unroll
    for (int j = 0; j < 4; ++j) {
        if (write_h) ((f32x4*)(P.H + (size_t)row * DM))[64 * j + lane] = v[j];
        u32x2 w; w.x = cvtpk(v[j][0], v[j][1]); w.y = cvtpk(v[j][2], v[j][3]); ((u32x2*)(P.HB + (size_t)row * DM))[64 * j + lane] = w; }
}
__device__ __forceinline__ void phase_prep(const Ptrs& P, LAS unsigned char* lds, int gw, int NGW, int wave, int lane) {
    convert_weights(P, 0, lds, gw, NGW, wave, lane);
    const int gt = gw * 64 + lane, NGT = NGW * 64;
    for (int i = gt; i < LSEQ * 48; i += NGT) {
        const int t = i / 48, k = i % 48; const float pos = (float)(t - NPAD);
        const float inv = (k < 32) ? ex2(-(float)k * (13.287712379549449f / 32.0f)) : ex2(-(float)(k - 32) * (13.287712379549449f / 16.0f));
        const float ang = pos * inv;
        double rev = (double)ang * 0.15915494309189535; rev -= floor(rev); const float fr = (float)rev;
        const f32x2 cs = {__builtin_amdgcn_cosf(fr), __builtin_amdgcn_sinf(fr)};
        if (k < 32) P.tab64[(size_t)t * 32 + k] = cs; else P.tab32[(size_t)t * 16 + (k - 32)] = cs;
    }
    for (int i = gt; i < DEPTH * 2 * MROWS; i += NGT) P.ssq[i] = 0.f;
    const float* x = P.in[0]; const float* meta = P.in[1]; const float* g = P.in[2]; const float* bta = P.in[3];
    for (int row = gw; row < MROWS; row += NGW) {
        const int b = row / LSEQ, t = row - b * LSEQ; f32x4 v[4];
#pragma unroll
        for (int j = 0; j < 4; ++j) {
            if (t < NPAD) v[j] = (f32x4){0.f, 0.f, 0.f, 0.f};
            else if (t < 128) v[j] = ((const f32x4*)(meta + (size_t)(t - NPAD) * DM))[64 * j + lane];
            else v[j] = ((const f32x4*)(x + ((size_t)b * SEQ + (t - 128)) * DM))[64 * j + lane]; }
        ln_regs(v, g, bta, lane);
        store_h_hb(P, row, v, lane, true);
    }
}
__device__ __forceinline__ void ln_store(const Ptrs& P, int row, const f32x4 (&v)[4], int lane, bool final_out) {
    if (!final_out) store_h_hb(P, row, v, lane, true);
    else { const int b = row / LSEQ, t = row - b * LSEQ;
        if (t >= 128) {
#pragma unroll
            for (int j = 0; j < 4; ++j) ((f32x4*)(P.out + ((size_t)b * SEQ + (t - 128)) * DM))[64 * j + lane] = v[j]; } }
}
__device__ __forceinline__ void phase_ln(const Ptrs& P, const float* g, const float* bta, bool final_out, int gw, int NGW, int lane) {
    int row = gw;
    for (; row + NGW < TAIL_ROW0; row += 2 * NGW) {
        f32x4 va[4], vb[4];
#pragma unroll
        for (int j = 0; j < 4; ++j) { va[j] = ((const f32x4*)(P.H + (size_t)row * DM))[64 * j + lane]; vb[j] = ((const f32x4*)(P.H + (size_t)(row + NGW) * DM))[64 * j + lane]; }
        ln_regs(va, g, bta, lane); ln_regs(vb, g, bta, lane);
        ln_store(P, row, va, lane, final_out); ln_store(P, row + NGW, vb, lane, final_out);
    }
    for (; row < MROWS; row += NGW) {
        f32x4 v[4];
#pragma unroll
        for (int j = 0; j < 4; ++j) v[j] = ((const f32x4*)(P.H + (size_t)row * DM))[64 * j + lane];
        if (row >= TAIL_ROW0) {
            const float* part = (const float*)(P.ws + WS_PART) + (size_t)(row - TAIL_ROW0) * DM;
#pragma unroll
            for (int j = 0; j < 4; ++j) { f32x4 sacc = ((const f32x4*)part)[64 * j + lane];
#pragma unroll
                for (int ks = 1; ks < NSPLIT; ++ks) sacc += ((const f32x4*)(part + (size_t)ks * 1024 * 1024))[64 * j + lane];
                v[j] = v[j] * DN_ALPHA + sacc; }
        }
        ln_regs(v, g, bta, lane);
        if (!final_out) store_h_hb(P, row, v, lane, true);
        else { const int b = row / LSEQ, t = row - b * LSEQ;
            if (t >= 128) {
#pragma unroll
                for (int j = 0; j < 4; ++j) ((f32x4*)(P.out + ((size_t)b * SEQ + (t - 128)) * DM))[64 * j + lane] = v[j]; } }
    }
}

#define XB_TMO      128
#define XB_XCNT(j)  (256  + 64 * (j))
#define XB_XSUB(j)  (1280 + 64 * (j))
#define XB_XGEN(j)  (2304 + 64 * (j))
#define XB_TOP      3328
#define XB_TOPGEN   3392
#define XCD_BAR_WORDS 3456
#define XB_SPIN_CAP (1u << 18)

__device__ __forceinline__ unsigned xb_ld(unsigned* p)              { return __hip_atomic_load(p, __ATOMIC_RELAXED, __HIP_MEMORY_SCOPE_AGENT); }
__device__ __forceinline__ unsigned xb_add(unsigned* p, unsigned v) { return __hip_atomic_fetch_add(p, v, __ATOMIC_RELAXED, __HIP_MEMORY_SCOPE_AGENT); }
__device__ __forceinline__ unsigned xb_xcc_id() { return (unsigned)__builtin_amdgcn_s_getreg((3 << 11) | 20) & 0xFu; }
#define XB_SPIN(cond, bar) do { unsigned _sp = 0; while (cond) { __builtin_amdgcn_s_sleep(1); \
    if ((++_sp & 255u) == 0u) { if (xb_ld(&(bar)[XB_TMO])) break; if (_sp > XB_SPIN_CAP) { atomicAdd(&(bar)[XB_TMO], 1u); break; } } } } while (0)

struct XcdBarrier {
    unsigned* bar; unsigned x;
    volatile LAS unsigned* st;
};

__device__ __forceinline__ XcdBarrier xcd_barrier_post(unsigned* bar, volatile LAS unsigned* st) {
    XcdBarrier b; b.bar = bar; b.x = xb_xcc_id(); b.st = st;
    if (threadIdx.x == 0) (void)xb_add(&bar[XB_XCNT(b.x)], 1u);
    return b;
}
__device__ __forceinline__ void xcd_barrier_complete(unsigned* bar, unsigned x, unsigned& nloc, unsigned& nx) {
    const unsigned G = gridDim.x * gridDim.y * gridDim.z;
    unsigned sum, cnt, mine, sp = 0u;
    for (;;) {
        sum = 0u; cnt = 0u; mine = 0u;
#pragma unroll
        for (unsigned j = 0; j < 16; ++j) { const unsigned c = xb_ld(&bar[XB_XCNT(j)]); sum += c; cnt += (c > 0u) ? 1u : 0u; mine = (j == x) ? c : mine; }
        if (sum == G) break;
        __builtin_amdgcn_s_sleep(1);
        if ((++sp & 255u) == 0u) { if (xb_ld(&bar[XB_TMO])) break; if (sp > XB_SPIN_CAP) { atomicAdd(&bar[XB_TMO], 1u); break; } }
    }
    nloc = mine > 0u ? mine : 1u; nx = cnt > 0u ? cnt : 1u;
}

__device__ __forceinline__ void xcd_barrier(const XcdBarrier& b) {
    asm volatile("s_waitcnt vmcnt(0)" ::: "memory");
    __syncthreads();
    if (threadIdx.x == 0) {
        unsigned* bar = b.bar;
        __builtin_amdgcn_s_waitcnt(0);
        unsigned nloc = b.st[0], nx = b.st[1];
        if (nloc == 0u) { xcd_barrier_complete(bar, b.x, nloc, nx); b.st[0] = nloc; b.st[1] = nx; }
        const unsigned old = xb_add(&bar[XB_XSUB(b.x)], 1u);
        const unsigned gen = old / nloc;
        if (old + 1u == (gen + 1u) * nloc) {
            __builtin_amdgcn_fence(__ATOMIC_RELEASE, "agent");
            asm volatile("s_waitcnt vmcnt(0)" ::: "memory");
            const unsigned og = xb_add(&bar[XB_TOP], 1u);
            const unsigned tg = og / nx;
            if (og + 1u == (tg + 1u) * nx) xb_add(&bar[XB_TOPGEN], 1u);
            else XB_SPIN(xb_ld(&bar[XB_TOPGEN]) == tg, bar);
            __builtin_amdgcn_fence(__ATOMIC_ACQUIRE, "agent");
            xb_add(&bar[XB_XGEN(b.x)], 1u);
            asm volatile("s_waitcnt vmcnt(0)" ::: "memory");
        } else {
            XB_SPIN(xb_ld(&bar[XB_XGEN(b.x)]) == gen, bar);
            __builtin_amdgcn_fence(__ATOMIC_ACQUIRE, "agent");
            asm volatile("s_waitcnt vmcnt(0)" ::: "memory");
        }
    }
    __syncthreads();
}

struct Args { const float* in[16]; float* out; unsigned char* ws; int ph_lo, ph_hi; };
static_assert(sizeof(Args) == 16 * 8 + 8 + 8 + 8, "Args has no padding");

template <class Epi>
__device__ __forceinline__ void run_gemm(LAS unsigned char* lds, const bf16* A, const bf16* Bt, int N, int K, const Epi& E, int rot = 0) {
    pg8::Gemm g{A, Bt, MROWS, N, K, K}; pg8::StaticOrder S; S.init(MROWS, N, (int)gridDim.x, ((int)blockIdx.x + rot) % (int)gridDim.x);
    pg8::gemm_phase<Epi, pg8::StaticOrder, true, true>(lds, g, S, E);
}
__device__ __forceinline__ void run_gemm_res(LAS unsigned char* lds, const bf16* A, const bf16* Bt, int K, float* H, float* PART) {
    const int rot = ((int)blockIdx.x + 128) % (int)gridDim.x;
    { EpiPart E{PART, K / 64 / NSPLIT}; pg8::Gemm g{A, Bt, MROWS, 1024, K / NSPLIT, K}; TailOrder S{(int)gridDim.x, rot, K / 64 / NSPLIT};
      pg8::gemm_phase<EpiPart, TailOrder, true, true>(lds, g, S, E); }
    { EpiRes E{H}; pg8::Gemm g{A, Bt, TAIL_ROW0, 1024, K, K}; pg8::StaticOrder S; S.init(TAIL_ROW0, 1024, (int)gridDim.x, (int)blockIdx.x);
      pg8::gemm_phase<EpiRes, pg8::StaticOrder, true, true>(lds, g, S, E); }
}

__global__ void __launch_bounds__(NTHREADS, 2) mk_fwd(Args a) {
    extern __shared__ __attribute__((aligned(16))) unsigned char lds_raw[];
    LAS unsigned char* lds = (LAS unsigned char*)lds_raw;
    volatile LAS unsigned* MISC = (volatile LAS unsigned*)(lds + 143360);
    if (threadIdx.x < 32) MISC[threadIdx.x] = 0u;
    __syncthreads();
    XcdBarrier xbar = xcd_barrier_post((unsigned*)(a.ws + WS_MISC + MISC_CTL) + 4096, MISC + 8);
    for (int ph = a.ph_lo; ph < a.ph_hi; ++ph) {
        int tid_l = threadIdx.x; asm volatile("" : "+v"(tid_l));
        const int tid = tid_l, lane = tid & 63, wave = __builtin_amdgcn_readfirstlane(tid >> 6);
        const int gw = (int)blockIdx.x * NWAVES + wave, NGW = (int)gridDim.x * NWAVES;
    size_t zoff = 0; asm volatile("" : "+s"(zoff));
    Ptrs P;
#pragma unroll
    for (int i = 0; i < 16; ++i) P.in[i] = a.in[i] + zoff;
    unsigned char* wsl = a.ws + zoff; float* outl = a.out + zoff;
    fill_ptrs(P, wsl, outl);
        if (ph == 0) phase_prep(P, lds, gw, NGW, wave, lane);
        else {
            const int l = (ph - 1) >> 3, s = (ph - 1) & 7;
            if (s == 0) {
#ifndef NO_IN
 EpiIn E{wsl, outl, l}; run_gemm(lds, P.HB, P.Win, NIN, 1024, E);
#endif
 }
            else if (s == 1) {
#ifndef NO_U
 { EpiUq E{wsl, outl, l}; run_gemm(lds, P.CQ, P.Wuq, 768, 384, E); } { EpiUkv E{wsl, outl, l}; run_gemm(lds, P.CKV, P.Wukv, 1024, 256, E, 104); }
 att::ret_state_jobs(P);
#endif
 }
            else if (s == 2) {
#ifndef NO_ATT
#ifdef PROBE_ATT
 const int nrep = 2 + (int)P.ctl[1];
#else
 const int nrep = 1;
#endif
 for (int rep = 0; rep < nrep; ++rep) att::phase(P, lds, P.ctl + 64 * (l + 1 + 8 * rep), rep == nrep - 1);
#endif
 }
            else if (s == 3) {
#ifndef NO_RES
 run_gemm_res(lds, P.MIX, P.Wout, 1536, P.H, (float*)(wsl + WS_PART));
#endif
 }
            else if (s == 4) phase_ln(P, P.in[10] + l * DM, P.in[11] + l * DM, false, gw, NGW, lane);
            else if (s == 5) {
#ifndef NO_FF
 EpiFf1 E{P.U};
#ifdef PROBE_FF1
 const int nrep1 = 2 + (int)P.ctl[1];
#else
 const int nrep1 = 1;
#endif
 for (int rep = 0; rep < nrep1; ++rep) run_gemm(lds, P.HB, P.W1, 4096, 1024, E);
#endif
 }
            else if (s == 6) {
#ifndef NO_RES
 run_gemm_res(lds, P.U, P.W2, 4096, P.H, (float*)(wsl + WS_PART));
#endif
 }
            else { if (l + 1 < DEPTH) convert_weights(P, l + 1, lds, gw, NGW, wave, lane);
                   phase_ln(P, P.in[14] + l * DM, P.in[15] + l * DM, l + 1 == DEPTH, gw, NGW, lane); }
        }
#ifndef T_NOSYNC
        if (ph + 1 < a.ph_hi) { if (ph == a.ph_lo) cg::this_grid().sync(); else xcd_barrier(xbar); }
#ifdef PROBE_SYNC
        if (ph + 1 < a.ph_hi) { cg::this_grid().sync(); cg::this_grid().sync(); }
#endif
#endif
    }
}

extern "C" void kernel_launch(void* const* d_in, const int* in_sizes, int n_in, void* d_out, int out_size, void* d_ws, size_t ws_size, hipStream_t stream) {
    static int grid = 0;
    if (grid == 0) {
        if (n_in != 16 || in_sizes[0] != BATCH * SEQ * DM || out_size != BATCH * SEQ * DM || ws_size < WS_END) {
            fprintf(stderr, "kernel_launch: unexpected shapes (n_in %d, in0 %d, out %d, ws %zu, need %zu); nothing launched\n", n_in, n_in > 0 ? in_sizes[0] : -1, out_size, ws_size, (size_t)WS_END); grid = -1; return; }
        int dev = 0, cus = 0, per_cu = 0;
        if (hipGetDevice(&dev) != hipSuccess || hipDeviceGetAttribute(&cus, hipDeviceAttributeMultiprocessorCount, dev) != hipSuccess) { grid = -1; return; }
        if (hipFuncSetAttribute((const void*)mk_fwd, hipFuncAttributeMaxDynamicSharedMemorySize, LDS_BYTES) != hipSuccess) { fprintf(stderr, "kernel_launch: hipFuncSetAttribute failed\n"); grid = -1; return; }
        if (hipOccupancyMaxActiveBlocksPerMultiprocessor(&per_cu, (const void*)mk_fwd, NTHREADS, LDS_BYTES) != hipSuccess || per_cu < 1) { fprintf(stderr, "kernel_launch: occupancy query says %d\n", per_cu); per_cu = 1; }
        (void)hipGetLastError();
        grid = cus * 1;
    }
    if (grid < 0) return;
    (void)hipMemsetAsync((char*)d_ws + WS_MISC + MISC_CTL, 0, CTL_BYTES, stream);
    Args a{};
    for (int i = 0; i < 16; ++i) a.in[i] = (const float*)d_in[i];
    a.out = (float*)d_out; a.ws = (unsigned char*)d_ws;
#if MK_SPLIT
    for (int ph = 0; ph < NPHASES; ++ph) { a.ph_lo = ph; a.ph_hi = ph + 1; hipLaunchKernelGGL(mk_fwd, dim3(grid), dim3(NTHREADS), LDS_BYTES, stream, a); }
#else
    a.ph_lo = 0; a.ph_hi = NPHASES;
    void* args[] = {&a};
    hipError_t e = hipLaunchCooperativeKernel((const void*)mk_fwd, dim3(grid), dim3(NTHREADS), args, LDS_BYTES, stream);
    if (e != hipSuccess) fprintf(stderr, "kernel_launch: cooperative launch failed: %s (grid %d)\n", hipGetErrorString(e), grid);
#endif
}
```

```cpp
#define TMASK 255
#include <hip/hip_runtime.h>
#include <hip/hip_cooperative_groups.h>
#include <cstdio>
#include <cstdint>
namespace cg = cooperative_groups;
#ifndef TMASK
#define TMASK 0
#endif
#ifndef MK_SPLIT
#define MK_SPLIT 0
#endif
namespace pg8 {
#define PG8_LAS __attribute__((address_space(3)))
typedef unsigned short bf16_t;
typedef short bf16x8 __attribute__((ext_vector_type(8)));
typedef float f32x4 __attribute__((ext_vector_type(4)));
typedef unsigned u32x4 __attribute__((ext_vector_type(4)));
constexpr int BM = 256, BK = 64, HALF = 128, HTB = HALF * BK * 2  , STAGE_BYTES = 8 * HTB, NXCD = 8, WGM = 8;

__host__ __device__ __forceinline__ int lds_byte(int r, int c) { const int st = (r >> 4) * 2 + (c >> 5), rr = r & 15, cc = c & 31, ob = rr * 64 + cc * 2; return st * 1024 + (ob ^ (((ob >> 9) & 1) << 5)); }
__host__ __device__ __forceinline__ void stage_rc(int b, int& R, int& C) { const int st = b / 1024, sb = b % 1024, swz = sb ^ (((sb >> 9) & 1) << 5); R = (st >> 1) * 16 + swz / 64; C = (st & 1) * 32 + (swz % 64) / 2; }
__host__ __device__ __forceinline__ int perm32(int rho) { const int n = rho >> 4, i = rho & 15; return 8 * (i >> 2) + 4 * n + (i & 3); }

struct Unit { int pm, pn, kt0; };
struct Gemm { const bf16_t* A; const bf16_t* Bt; int M, N, K, ld; };

struct StaticOrder {
    int nM, nN, nwg, G, c;
    __host__ __device__ void init(int M, int N, int G_, int c_) { nM = M / BM; nN = N / BM; nwg = nM * nN; G = G_; c = c_; }
    __host__ __device__ bool next(int i, Unit& u) const {
        const long L = (long)i * G + c; if (L >= nwg) return false;
        int wgid = (int)L; { const int q = nwg / NXCD, r = nwg % NXCD, xcd = wgid % NXCD, off = wgid / NXCD; wgid = (xcd < r ? xcd * (q + 1) : r * (q + 1) + (xcd - r) * q) + off; }
        const int nig = WGM * nN, gid = wgid / nig, fm = gid * WGM, gsz = (nM - fm) < WGM ? (nM - fm) : WGM;
        u.pm = fm + ((wgid % nig) % gsz); u.pn = (wgid % nig) / gsz; u.kt0 = 0; return true;
    }
    __device__ __forceinline__ void a_ready(const Unit&) const {}
    __device__ __forceinline__ void done(const Unit&) const {}
};
template <class Epi, class Sched, bool ALIGN_EPI = false, bool SP2 = false>
__device__ __forceinline__ void gemm_phase(PG8_LAS unsigned char* lds, const Gemm g, const Sched& S, const Epi& E) {
    int tid_l = threadIdx.x; asm volatile("" : "+v"(tid_l));
    const int tid = tid_l, wid = __builtin_amdgcn_readfirstlane(tid >> 6), lane = tid & 63, wr = wid >> 2, wc = wid & 3, fr = lane & 15, fq = lane >> 4;
    const int K = g.K, nt = K / BK;
    unsigned voffA[2], voffB[2];
#pragma unroll
    for (int i = 0; i < 2; ++i) { int R, C; stage_rc(tid * 16 + i * 8192, R, C); const int Rb = Epi::PERM ? ((R & ~31) + perm32(R & 31)) : R;
        voffA[i] = (unsigned)(R * g.ld + C) * 2u; voffB[i] = (unsigned)(Rb * g.ld + C) * 2u; }
    const size_t kstep = (size_t)(BK * 2);
    const size_t hstep = (size_t)HALF * g.ld * 2;
    const size_t tstep = 2 * hstep;
    const unsigned ldsw = (unsigned)wid * 1024u;
    const int aoff = lds_byte(wr * 64 + fr, fq * 8), boff = lds_byte(wc * 32 + fr, fq * 8);
#define PG8_SA(b, h) (((b) * 2 + (h)) * HTB)
#define PG8_SB(b, h) ((4 + (b) * 2 + (h)) * HTB)
#define PG8_STAGE(bufoff, gbase, voff) do { _Pragma("unroll") for (int _i = 0; _i < 2; ++_i) \
        __builtin_amdgcn_global_load_lds((const unsigned*)((const char*)(gbase) + (voff)[_i]), (PG8_LAS unsigned*)(lds + (bufoff) + ldsw + _i * 8192), 16, 0, 0); } while (0)
#define PG8_LDA(dst, b, h) do { _Pragma("unroll") for (int m = 0; m < 4; ++m) _Pragma("unroll") for (int k = 0; k < 2; ++k) dst[m][k] = *(const PG8_LAS bf16x8*)(lds + PG8_SA(b, h) + aoff + m * 2048 + k * 1024); } while (0)
#define PG8_LDB(dst, b, h) do { _Pragma("unroll") for (int n = 0; n < 2; ++n) _Pragma("unroll") for (int k = 0; k < 2; ++k) dst[n][k] = *(const PG8_LAS bf16x8*)(lds + PG8_SB(b, h) + boff + n * 2048 + k * 1024); } while (0)
#define PG8_MMA(ai, bj, At, Bt) do { __builtin_amdgcn_s_setprio(1); _Pragma("unroll") for (int m = 0; m < 4; ++m) _Pragma("unroll") for (int n = 0; n < 2; ++n) _Pragma("unroll") for (int k = 0; k < 2; ++k) \
        acc[ai][bj][m][n] = __builtin_amdgcn_mfma_f32_16x16x32_bf16(Bt[n][k], At[m][k], acc[ai][bj][m][n], 0, 0, 0); __builtin_amdgcn_s_setprio(0); } while (0)
#define PG8_WAIT_V(n) asm volatile("s_waitcnt vmcnt(" #n ")" ::: "memory")
#define PG8_WAIT_L(n) asm volatile("s_waitcnt lgkmcnt(" #n ")" ::: "memory")
#define PG8_BAR __builtin_amdgcn_s_barrier()
#define PG8_SCHED __builtin_amdgcn_sched_barrier(0)
    Unit cur, nxt; int ui = 0;
    if (!S.next(0, cur)) return;
    f32x4 acc[2][2][4][2];
#pragma unroll
    for (int a = 0; a < 2; ++a)
#pragma unroll
        for (int b = 0; b < 2; ++b)
#pragma unroll
            for (int m = 0; m < 4; ++m)
#pragma unroll
                for (int n = 0; n < 2; ++n) acc[a][b][m][n] = (f32x4){0.f, 0.f, 0.f, 0.f};
    bf16x8 At[4][2], B0[2][2], B1[2][2];
    const char* cA = (const char*)g.A + (size_t)cur.pm * tstep + (size_t)cur.kt0 * kstep; const char* cB = (const char*)g.Bt + (size_t)cur.pn * tstep + (size_t)cur.kt0 * kstep;
    S.a_ready(cur);
    if constexpr (SP2) {
        PG8_STAGE(PG8_SB(0, 0), cB, voffB); PG8_STAGE(PG8_SB(0, 1), cB + hstep, voffB); PG8_STAGE(PG8_SA(0, 0), cA, voffA); PG8_STAGE(PG8_SA(0, 1), cA + hstep, voffA);
        if (wr == 1) PG8_BAR;
        PG8_WAIT_V(2); PG8_BAR;
        PG8_STAGE(PG8_SB(1, 0), cB + kstep, voffB); PG8_STAGE(PG8_SA(1, 0), cA + kstep, voffA); PG8_STAGE(PG8_SB(1, 1), cB + hstep + kstep, voffB);
        PG8_WAIT_V(6); PG8_BAR;
    } else {
        PG8_STAGE(PG8_SB(0, 0), cB, voffB); PG8_STAGE(PG8_SA(0, 0), cA, voffA); PG8_STAGE(PG8_SB(0, 1), cB + hstep, voffB); PG8_STAGE(PG8_SA(0, 1), cA + hstep, voffA);
        if (wr == 1) PG8_BAR;
        PG8_WAIT_V(4); PG8_BAR;
        PG8_STAGE(PG8_SB(1, 0), cB + kstep, voffB); PG8_STAGE(PG8_SA(1, 0), cA + kstep, voffA); PG8_STAGE(PG8_SB(1, 1), cB + hstep + kstep, voffB);
        PG8_WAIT_V(6); PG8_BAR;
    }
    for (;;) {
        const bool has_next = S.next(ui + 1, nxt);
        const char* nA = has_next ? (const char*)g.A + (size_t)nxt.pm * tstep + (size_t)nxt.kt0 * kstep : cA; const char* nB = has_next ? (const char*)g.Bt + (size_t)nxt.pn * tstep + (size_t)nxt.kt0 * kstep : cB;
        for (int t = 0; t < nt; t += 2) {
            const bool last = (t == nt - 2);
            const char* a1 = cA + (size_t)(t + 1) * kstep;
            const char* a2 = last ? nA : cA + (size_t)(t + 2) * kstep; const char* b2 = last ? nB : cB + (size_t)(t + 2) * kstep;
            const char* a3 = a2 + kstep; const char* b3 = b2 + kstep;
            if (last && has_next) S.a_ready(nxt);
            if constexpr (SP2) {
            PG8_LDB(B0, 0, 0); PG8_LDB(B1, 0, 1); PG8_SCHED; PG8_LDA(At, 0, 0); PG8_STAGE(PG8_SA(1, 1), a1 + hstep, voffA);
            PG8_WAIT_V(8); PG8_WAIT_L(0); PG8_BAR; PG8_MMA(0, 0, At, B0); PG8_MMA(0, 1, At, B1); PG8_BAR; PG8_SCHED;
            PG8_LDA(At, 0, 1); PG8_STAGE(PG8_SB(0, 0), b2, voffB); PG8_STAGE(PG8_SB(0, 1), b2 + hstep, voffB); PG8_STAGE(PG8_SA(0, 0), a2, voffA);
            PG8_WAIT_V(8); PG8_WAIT_L(0); PG8_BAR; PG8_MMA(1, 0, At, B0); PG8_MMA(1, 1, At, B1); PG8_BAR; PG8_SCHED;
            PG8_LDB(B0, 1, 0); PG8_LDB(B1, 1, 1); PG8_SCHED; PG8_LDA(At, 1, 0); PG8_STAGE(PG8_SA(0, 1), a2 + hstep, voffA);
            PG8_WAIT_V(8); PG8_WAIT_L(0); PG8_BAR; PG8_MMA(0, 0, At, B0); PG8_MMA(0, 1, At, B1); PG8_BAR; PG8_SCHED;
            PG8_LDA(At, 1, 1); PG8_STAGE(PG8_SB(1, 0), b3, voffB); PG8_STAGE(PG8_SB(1, 1), b3 + hstep, voffB); PG8_STAGE(PG8_SA(1, 0), a3, voffA);
            PG8_WAIT_V(8); PG8_WAIT_L(0); PG8_BAR; PG8_MMA(1, 0, At, B0); PG8_MMA(1, 1, At, B1); PG8_BAR; PG8_SCHED;
            } else {
            PG8_LDB(B0, 0, 0); PG8_SCHED; PG8_LDA(At, 0, 0); PG8_STAGE(PG8_SA(1, 1), a1 + hstep, voffA);
            PG8_WAIT_L(8); PG8_BAR; PG8_WAIT_L(0); PG8_MMA(0, 0, At, B0); PG8_BAR; PG8_SCHED;
            PG8_LDB(B1, 0, 1); PG8_STAGE(PG8_SB(0, 0), b2, voffB);
            PG8_BAR; PG8_WAIT_L(0); PG8_MMA(0, 1, At, B1); PG8_BAR;
            PG8_LDA(At, 0, 1); PG8_STAGE(PG8_SA(0, 0), a2, voffA);
            PG8_BAR; PG8_WAIT_L(0); PG8_MMA(1, 0, At, B0); PG8_BAR; PG8_SCHED;
            PG8_STAGE(PG8_SB(0, 1), b2 + hstep, voffB);
            PG8_WAIT_V(6); PG8_BAR; PG8_MMA(1, 1, At, B1); PG8_BAR;
            PG8_LDB(B0, 1, 0); PG8_SCHED; PG8_LDA(At, 1, 0); PG8_STAGE(PG8_SA(0, 1), a2 + hstep, voffA);
            PG8_WAIT_L(8); PG8_BAR; PG8_WAIT_L(0); PG8_MMA(0, 0, At, B0); PG8_BAR; PG8_SCHED;
            PG8_LDB(B1, 1, 1); PG8_STAGE(PG8_SB(1, 0), b3, voffB);
            PG8_BAR; PG8_WAIT_L(0); PG8_MMA(0, 1, At, B1); PG8_BAR;
            PG8_LDA(At, 1, 1); PG8_STAGE(PG8_SA(1, 0), a3, voffA);
            PG8_BAR; PG8_WAIT_L(0); PG8_MMA(1, 0, At, B0); PG8_BAR; PG8_SCHED;
            PG8_STAGE(PG8_SB(1, 1), b3 + hstep, voffB);
            PG8_WAIT_V(6); PG8_BAR; PG8_MMA(1, 1, At, B1); PG8_BAR;
            }
        }
        if constexpr (ALIGN_EPI) { if (wr == 0) PG8_BAR; }
        if constexpr (!Epi::AFTER_DRAIN) { E(acc, cur, wr, wc, fr, fq); S.done(cur); }
        if (!has_next) break;
#pragma unroll
        for (int a = 0; a < 2; ++a)
#pragma unroll
            for (int b = 0; b < 2; ++b)
#pragma unroll
                for (int m = 0; m < 4; ++m)
#pragma unroll
                    for (int n = 0; n < 2; ++n) acc[a][b][m][n] = (f32x4){0.f, 0.f, 0.f, 0.f};
        cur = nxt; cA = nA; cB = nB; ++ui;
        if constexpr (ALIGN_EPI) { if (wr == 1) PG8_BAR; }
    }
    PG8_WAIT_V(0);
    if constexpr (!ALIGN_EPI) { if (wr == 0) PG8_BAR; }
    PG8_BAR;
    if constexpr (Epi::AFTER_DRAIN) { E.fused(acc, cur, wr, wc, fr, fq, lds, wid, lane); S.done(cur); }
#undef PG8_SA
#undef PG8_SB
#undef PG8_STAGE
#undef PG8_LDA
#undef PG8_LDB
#undef PG8_MMA
#undef PG8_WAIT_V
#undef PG8_WAIT_L
#undef PG8_BAR
#undef PG8_SCHED
}
}

constexpr int BATCH = 8, SEQ = 4096, DM = 1024, DEPTH = 4, NPAD = 112, LSEQ = 4224, MROWS = BATCH * LSEQ;
constexpr int NIN_LOG = 3744, NIN = 3840, DFF = 4096, DMIX = 1536;
constexpr float LN_EPS = 1e-5f, DN_ALPHA = 1.681792830507429f;
constexpr int NWAVES = 8, NTHREADS = 512;
constexpr int LDS_BYTES = 147456;
constexpr int NPHASES = 1 + 8 * DEPTH;

typedef unsigned short bf16;
typedef float f32x4 __attribute__((ext_vector_type(4)));
typedef float f32x2 __attribute__((ext_vector_type(2)));
typedef float f32x16 __attribute__((ext_vector_type(16)));
typedef short bf16x8 __attribute__((ext_vector_type(8)));
typedef unsigned u32x2 __attribute__((ext_vector_type(2)));
typedef unsigned u32x4 __attribute__((ext_vector_type(4)));
typedef __bf16 bf16x2_t __attribute__((ext_vector_type(2)));
#define LAS __attribute__((address_space(3)))

constexpr size_t MiB = 1u << 20;
constexpr size_t WS_H = 0, WS_HB = 132 * MiB, WS_W = 198 * MiB, WS_MISC = 226 * MiB, WS_B = 230 * MiB, WS_PART = 494 * MiB, WS_END = 510 * MiB;
constexpr size_t W_IN = 0, W_UQ = W_IN + (size_t)NIN * 1024 * 2, W_UKV = W_UQ + (size_t)768 * 384 * 2, W_OUT = W_UKV + (size_t)1024 * 256 * 2,
                 W_FF1 = W_OUT + (size_t)1024 * 1536 * 2, W_FF2 = W_FF1 + (size_t)4096 * 1024 * 2, W_TOTAL = W_FF2 + (size_t)1024 * 4096 * 2;
static_assert(W_TOTAL <= 28 * MiB, "weights region");
constexpr size_t MISC_CTL = 0, CTL_BYTES = 65536, MISC_TAB64 = 65536, MISC_TAB32 = MISC_TAB64 + (size_t)LSEQ * 32 * 8, MISC_SSQ = MISC_TAB32 + (size_t)LSEQ * 16 * 8,
                 MISC_END = MISC_SSQ + (size_t)12 * MROWS * 4;
static_assert(MISC_END <= 4 * MiB, "misc region");
constexpr size_t B_MIX = 0, B_KSB = 99 * MiB, B_VTSB = 132 * MiB, B_RQ = 165 * MiB, B_RK = B_RQ + 33 * MiB / 2, B_RVT = 198 * MiB, B_KN = 231 * MiB, B_U = 0;
constexpr size_t O_VTMLA = 0, O_CQ = 33 * MiB, O_CKV = O_CQ + (size_t)MROWS * 384 * 2, O_QR = O_CKV + (size_t)MROWS * 256 * 2, O_KR = O_QR + (size_t)MROWS * 256 * 2, O_END = O_KR + (size_t)MROWS * 32 * 2;
constexpr size_t O_DT = 93 * MiB, O_RKT = 109 * MiB;
static_assert(O_END <= O_DT && O_RKT + (size_t)MROWS * 256 * 2 <= 128 * MiB, "d_out scratch");

__device__ __forceinline__ unsigned f2bf(float f) { unsigned u = __builtin_bit_cast(unsigned, f); return (u + 0x7fffu + ((u >> 16) & 1u)) >> 16; }
__device__ __forceinline__ unsigned cvtpk(float lo, float hi) { f32x2 v = {lo, hi}; bf16x2_t b = __builtin_convertvector(v, bf16x2_t); return __builtin_bit_cast(unsigned, b); }
__device__ __forceinline__ float bf2f(unsigned short b) { return __builtin_bit_cast(float, (unsigned)b << 16); }
__device__ __forceinline__ float ex2(float x) { return __builtin_amdgcn_exp2f(x); }
__device__ __forceinline__ float wave_sum(float v) {
#pragma unroll
    for (int o = 1; o < 64; o <<= 1) v += __shfl_xor(v, o);
    return v;
}
__device__ __forceinline__ float ret_lg(int h) {
    return h == 0 ? -0.04580368961312479f : h == 1 ? -0.02272007650008353f : h == 2 ? -0.011315313227834146f : -0.005646563141142063f;
}

struct Ptrs {
    const float* in[16]; float* out; unsigned char* ws;
    float* H; bf16* HB; bf16* Win; bf16* Wuq; bf16* Wukv; bf16* Wout; bf16* W1; bf16* W2;
    unsigned* ctl; f32x2* tab64; f32x2* tab32; float* ssq;
    bf16 *MIX, *KSB, *VTSB, *RQ, *RK, *RVT, *KN, *U, *VTMLA, *CQ, *CKV, *QR, *KR, *RKT; float* DT;
};

#define GAS __attribute__((address_space(1)))
__device__ __forceinline__ void fill_ptrs(Ptrs& P, unsigned char* wsl_, float* outl_) {
    unsigned char* wsl = (unsigned char*)(GAS unsigned char*)wsl_; float* outl = (float*)(GAS float*)outl_;
    P.out = outl; P.ws = wsl;
    P.H = (float*)(wsl + WS_H); P.HB = (bf16*)(wsl + WS_HB);
    unsigned char* wb = wsl + WS_W;
    P.Win = (bf16*)(wb + W_IN); P.Wuq = (bf16*)(wb + W_UQ); P.Wukv = (bf16*)(wb + W_UKV); P.Wout = (bf16*)(wb + W_OUT); P.W1 = (bf16*)(wb + W_FF1); P.W2 = (bf16*)(wb + W_FF2);
    unsigned char* mb = wsl + WS_MISC;
    P.ctl = (unsigned*)(mb + MISC_CTL); P.tab64 = (f32x2*)(mb + MISC_TAB64); P.tab32 = (f32x2*)(mb + MISC_TAB32); P.ssq = (float*)(mb + MISC_SSQ);
    unsigned char* bb = wsl + WS_B;
    P.MIX = (bf16*)(bb + B_MIX); P.KSB = (bf16*)(bb + B_KSB); P.VTSB = (bf16*)(bb + B_VTSB); P.RQ = (bf16*)(bb + B_RQ); P.RK = (bf16*)(bb + B_RK); P.RVT = (bf16*)(bb + B_RVT);
    P.KN = (bf16*)(bb + B_KN); P.U = (bf16*)(bb + B_U);
    unsigned char* ob = (unsigned char*)outl;
    P.VTMLA = (bf16*)(ob + O_VTMLA); P.CQ = (bf16*)(ob + O_CQ); P.CKV = (bf16*)(ob + O_CKV); P.QR = (bf16*)(ob + O_QR); P.KR = (bf16*)(ob + O_KR); P.RKT = (bf16*)(ob + O_RKT); P.DT = (float*)(ob + O_DT);
}
#define EPI_PTRS Ptrs P; { size_t z_ = 0; asm volatile("" : "+s"(z_)); fill_ptrs(P, ws_ + z_, out_ + z_); } \
                 float* ssq_q = P.ssq; float* ssq_kv = P.ssq + (size_t)8 * MROWS; (void)ssq_q; (void)ssq_kv; (void)layer_;
using pg8::Unit;
#define EPI_ROWS_BEGIN  _Pragma("unroll") for (int ai = 0; ai < 2; ++ai) _Pragma("unroll") for (int m = 0; m < 4; ++m) { const int row = u.pm * 256 + ai * 128 + wr * 64 + m * 16 + fr; const int cl = wc * 32 + fq * 4; (void)cl;
#define EPI_ROWS_END    asm volatile("" ::: "memory"); }
#define EPI_COLS_BEGIN  _Pragma("unroll") for (int bj = 0; bj < 2; ++bj) _Pragma("unroll") for (int n = 0; n < 2; ++n) { const int co = bj * 128 + n * 16; const int c = co + cl; (void)c; const f32x4 v = acc[ai][bj][m][n];
#define EPI_COLS_END    }

__device__ __forceinline__ void st_bf4(bf16* p, f32x4 v) { u32x2 w; w.x = cvtpk(v[0], v[1]); w.y = cvtpk(v[2], v[3]); *(u32x2*)p = w; }

struct EpiIn {
    static constexpr bool PERM = false, AFTER_DRAIN = false;
    unsigned char* ws_; float* out_; int layer_;
    __device__ __forceinline__ void plain(const f32x4 (&acc)[2][2][4][2], const Unit& u, int wr, int wc, int fr, int fq, bf16* dst, int ld, int col0) const {
        EPI_ROWS_BEGIN
            bf16* rp = dst + (unsigned)(row * ld + col0 + cl);
            EPI_COLS_BEGIN st_bf4(rp + co, v); EPI_COLS_END
        EPI_ROWS_END
    }
    template <int HD> __device__ __forceinline__ void transposed(const f32x4 (&acc)[2][2][4][2], const Unit& u, int wr, int wc, int fr, int fq, bf16* dst, int cc0) const {
        constexpr int NH = 512 / HD;
        EPI_ROWS_BEGIN
            const int b = row / LSEQ, t = row - b * LSEQ;
            EPI_COLS_BEGIN
                const int cc = cc0 + c, head = cc / HD, d = cc % HD;
                bf16* q = dst + ((size_t)(b * NH + head) * HD + d) * LSEQ + t;
                q[0] = (bf16)f2bf(v[0]); q[LSEQ] = (bf16)f2bf(v[1]); q[2 * LSEQ] = (bf16)f2bf(v[2]); q[3 * LSEQ] = (bf16)f2bf(v[3]);
            EPI_COLS_END
        EPI_ROWS_END
    }
    __device__ __forceinline__ void withssq(const f32x4 (&acc)[2][2][4][2], const Unit& u, int wr, int wc, int fr, int fq, bf16* dst, int ld, int col0, float* ssq, int nbj, int nslot, int slot0) const {
        EPI_ROWS_BEGIN
            float s = 0.f; bf16* rp = dst + (unsigned)(row * ld + col0 + cl);
#pragma unroll
            for (int bj = 0; bj < 2; ++bj) if (bj < nbj) {
#pragma unroll
                for (int n = 0; n < 2; ++n) { const f32x4 v = acc[ai][bj][m][n];
                    st_bf4(rp + bj * 128 + n * 16, v); s += (v[0] * v[0] + v[1] * v[1]) + (v[2] * v[2] + v[3] * v[3]); } }
            s += __shfl_xor(s, 16); s += __shfl_xor(s, 32);
            if (fq == 0) ssq[(unsigned)(row * nslot + slot0 + wc)] = s;
        EPI_ROWS_END
    }
    template <bool ISK> __device__ __forceinline__ void rope64(const Ptrs& P, const f32x4 (&acc)[2][2][4][2], const Unit& u, int wr, int wc, int fr, int fq, bf16* dst) const {
        EPI_ROWS_BEGIN
            const int b = row / LSEQ, t = row - b * LSEQ; const int d0 = 16 * (wc & 1) + 4 * fq;
            const f32x4* tp = (const f32x4*)(P.tab64 + (size_t)t * 32 + d0); const f32x4 cs0 = tp[0], cs1 = tp[1];
#pragma unroll
            for (int bj = 0; bj < 2; ++bj) { const int hd = 2 * bj + (wc >> 1); const f32x4 x1 = acc[ai][bj][m][0], x2 = acc[ai][bj][m][1];
                float f;
                if (ISK) f = (t >= NPAD) ? ex2(-(float)(t & 63) * ret_lg(hd)) : 0.f; else f = ex2((float)(t & 31) * ret_lg(hd));
                f32x4 o1, o2;
                o1[0] = (x1[0] * cs0[0] - x2[0] * cs0[1]) * f; o2[0] = (x1[0] * cs0[1] + x2[0] * cs0[0]) * f;
                o1[1] = (x1[1] * cs0[2] - x2[1] * cs0[3]) * f; o2[1] = (x1[1] * cs0[3] + x2[1] * cs0[2]) * f;
                o1[2] = (x1[2] * cs1[0] - x2[2] * cs1[1]) * f; o2[2] = (x1[2] * cs1[1] + x2[2] * cs1[0]) * f;
                o1[3] = (x1[3] * cs1[2] - x2[3] * cs1[3]) * f; o2[3] = (x1[3] * cs1[3] + x2[3] * cs1[2]) * f;
                bf16* q = dst + (size_t)row * 256 + 64 * hd + d0; st_bf4(q, o1); st_bf4(q + 32, o2);
                if (ISK) { bf16* qt = P.RKT + ((size_t)(b * 4 + hd) * 64 + d0) * LSEQ + t;
#pragma unroll
                    for (int j = 0; j < 4; ++j) { qt[(size_t)j * LSEQ] = (bf16)f2bf(o1[j]); qt[(size_t)(32 + j) * LSEQ] = (bf16)f2bf(o2[j]); } } }
        EPI_ROWS_END
    }
    __device__ __forceinline__ void operator()(const f32x4 (&acc)[2][2][4][2], const Unit& u, int wr, int wc, int fr, int fq) const {
        const int pn = u.pn; EPI_PTRS
        if (pn < 2) plain(acc, u, wr, wc, fr, fq, P.MIX, DMIX, pn * 256);
        else if (pn < 4) plain(acc, u, wr, wc, fr, fq, P.KSB, 512, (pn - 2) * 256);
        else if (pn < 6) transposed<64>(acc, u, wr, wc, fr, fq, P.VTSB, (pn - 4) * 256);
        else if (pn == 6) rope64<false>(P, acc, u, wr, wc, fr, fq, P.RQ);
        else if (pn == 7) rope64<true>(P, acc, u, wr, wc, fr, fq, P.RK);
        else if (pn < 10) transposed<128>(acc, u, wr, wc, fr, fq, P.RVT, (pn - 8) * 256);
        else if (pn < 12) plain(acc, u, wr, wc, fr, fq, P.MIX, DMIX, 1024 + (pn - 10) * 256);
        else if (pn == 12) withssq(acc, u, wr, wc, fr, fq, P.CKV, 256, 0, ssq_kv, 2, 4, 0);
        else if (pn == 13) withssq(acc, u, wr, wc, fr, fq, P.CQ, 384, 0, ssq_q, 2, 8, 0);
        else {
            withssq(acc, u, wr, wc, fr, fq, P.CQ, 384, 256, ssq_q, 1, 8, 4);
            if (wc == 0) {
                EPI_ROWS_BEGIN
                    const int b = row / LSEQ, t = row - b * LSEQ;
                    const f32x4* tp = (const f32x4*)(P.tab32 + (size_t)t * 16 + 4 * fq); const f32x4 cs0 = tp[0], cs1 = tp[1];
                    const f32x4 x1 = acc[ai][1][m][0], x2 = acc[ai][1][m][1]; f32x4 o1, o2;
                    o1[0] = x1[0] * cs0[0] - x2[0] * cs0[1]; o2[0] = x1[0] * cs0[1] + x2[0] * cs0[0];
                    o1[1] = x1[1] * cs0[2] - x2[1] * cs0[3]; o2[1] = x1[1] * cs0[3] + x2[1] * cs0[2];
                    o1[2] = x1[2] * cs1[0] - x2[2] * cs1[1]; o2[2] = x1[2] * cs1[1] + x2[2] * cs1[0];
                    o1[3] = x1[3] * cs1[2] - x2[3] * cs1[3]; o2[3] = x1[3] * cs1[3] + x2[3] * cs1[2];
                    bf16* q = P.KR + (size_t)row * 32 + 4 * fq; st_bf4(q, o1); st_bf4(q + 16, o2);
                EPI_ROWS_END
            }
        }
    }
};

struct EpiUq {
    static constexpr bool PERM = false, AFTER_DRAIN = false;
    unsigned char* ws_; float* out_; int layer_;
    __device__ __forceinline__ void operator()(const f32x4 (&acc)[2][2][4][2], const Unit& u, int wr, int wc, int fr, int fq) const {
        const int pn = u.pn; EPI_PTRS
        if (pn < 2) {
            EPI_ROWS_BEGIN
                const f32x4 sa_ = *(const f32x4*)(ssq_q + (size_t)row * 8), sb_ = *(const f32x4*)(ssq_q + (size_t)row * 8 + 4); const float ri = 1.0f / sqrtf((((sa_[0] + sa_[1]) + (sa_[2] + sa_[3])) + ((sb_[0] + sb_[1]) + (sb_[2] + sb_[3]))) * (1.0f / 384.0f) + LN_EPS);
                bf16* rp = P.MIX + (unsigned)(row * DMIX + 512 + pn * 256 + cl);
                EPI_COLS_BEGIN st_bf4(rp + co, v * ri); EPI_COLS_END
            EPI_ROWS_END
        } else {
            EPI_ROWS_BEGIN
                const f32x4 sa_ = *(const f32x4*)(ssq_q + (size_t)row * 8), sb_ = *(const f32x4*)(ssq_q + (size_t)row * 8 + 4); const float ri = 1.0f / sqrtf((((sa_[0] + sa_[1]) + (sa_[2] + sa_[3])) + ((sb_[0] + sb_[1]) + (sb_[2] + sb_[3]))) * (1.0f / 384.0f) + LN_EPS);
                const int b = row / LSEQ, t = row - b * LSEQ;
                const f32x4* tp = (const f32x4*)(P.tab32 + (size_t)t * 16 + 4 * fq); const f32x4 cs0 = tp[0], cs1 = tp[1];
#pragma unroll
                for (int bj = 0; bj < 2; ++bj) { const int head = 4 * bj + wc; const f32x4 x1 = acc[ai][bj][m][0] * ri, x2 = acc[ai][bj][m][1] * ri; f32x4 o1, o2;
                    o1[0] = x1[0] * cs0[0] - x2[0] * cs0[1]; o2[0] = x1[0] * cs0[1] + x2[0] * cs0[0];
                    o1[1] = x1[1] * cs0[2] - x2[1] * cs0[3]; o2[1] = x1[1] * cs0[3] + x2[1] * cs0[2];
                    o1[2] = x1[2] * cs1[0] - x2[2] * cs1[1]; o2[2] = x1[2] * cs1[1] + x2[2] * cs1[0];
                    o1[3] = x1[3] * cs1[2] - x2[3] * cs1[3]; o2[3] = x1[3] * cs1[3] + x2[3] * cs1[2];
                    bf16* q = P.QR + (size_t)row * 256 + 32 * head + 4 * fq; st_bf4(q, o1); st_bf4(q + 16, o2); }
            EPI_ROWS_END
        }
    }
};

struct EpiUkv {
    static constexpr bool PERM = false, AFTER_DRAIN = false;
    unsigned char* ws_; float* out_; int layer_;
    __device__ __forceinline__ void operator()(const f32x4 (&acc)[2][2][4][2], const Unit& u, int wr, int wc, int fr, int fq) const {
        const int pn = u.pn; EPI_PTRS
        if (pn < 2) {
            EPI_ROWS_BEGIN
                const f32x4 sa_ = *(const f32x4*)(ssq_kv + (size_t)row * 4); const float ri = 1.0f / sqrtf(((sa_[0] + sa_[1]) + (sa_[2] + sa_[3])) * (1.0f / 256.0f) + LN_EPS);
                bf16* rp = P.KN + (unsigned)(row * 512 + pn * 256 + cl);
                EPI_COLS_BEGIN st_bf4(rp + co, v * ri); EPI_COLS_END
            EPI_ROWS_END
        } else {
            EPI_ROWS_BEGIN
                const f32x4 sa_ = *(const f32x4*)(ssq_kv + (size_t)row * 4); const float ri = 1.0f / sqrtf(((sa_[0] + sa_[1]) + (sa_[2] + sa_[3])) * (1.0f / 256.0f) + LN_EPS);
                const int b = row / LSEQ, t = row - b * LSEQ;
                EPI_COLS_BEGIN
                    const int cc = (pn - 2) * 256 + c, head = cc >> 6, d = cc & 63;
                    bf16* q = P.VTMLA + ((size_t)(b * 8 + head) * 64 + d) * LSEQ + t;
                    q[0] = (bf16)f2bf(v[0] * ri); q[LSEQ] = (bf16)f2bf(v[1] * ri); q[2 * LSEQ] = (bf16)f2bf(v[2] * ri); q[3 * LSEQ] = (bf16)f2bf(v[3] * ri);
                EPI_COLS_END
            EPI_ROWS_END
        }
    }
};

struct EpiRes {
    static constexpr bool PERM = true, AFTER_DRAIN = false;
    float* H;
    __device__ __forceinline__ void operator()(const f32x4 (&acc)[2][2][4][2], const Unit& u, int wr, int wc, int fr, int fq) const {
        EPI_ROWS_BEGIN
            float* rp = H + (unsigned)(row * DM + u.pn * 256 + wc * 32 + fq * 8);
#pragma unroll
            for (int bj = 0; bj < 2; ++bj) { f32x4* q = (f32x4*)(rp + bj * 128); const f32x4 h0 = q[0], h1 = q[1];
                q[0] = h0 * DN_ALPHA + acc[ai][bj][m][0]; q[1] = h1 * DN_ALPHA + acc[ai][bj][m][1]; }
        EPI_ROWS_END
    }
};

struct EpiResT {
    static constexpr bool PERM = true, AFTER_DRAIN = false;
    bf16* T;
    __device__ __forceinline__ void operator()(const f32x4 (&acc)[2][2][4][2], const Unit& u, int wr, int wc, int fr, int fq) const {
        EPI_ROWS_BEGIN
            bf16* rp = T + (unsigned)(row * DM + u.pn * 256 + wc * 32 + fq * 8);
#pragma unroll
            for (int bj = 0; bj < 2; ++bj) { const f32x4 a0 = acc[ai][bj][m][0], a1 = acc[ai][bj][m][1];
                *(u32x4*)(rp + bj * 128) = (u32x4){cvtpk(a0[0], a0[1]), cvtpk(a0[2], a0[3]), cvtpk(a1[0], a1[1]), cvtpk(a1[2], a1[3])}; }
        EPI_ROWS_END
    }
};

struct EpiFf1 {
    static constexpr bool PERM = true, AFTER_DRAIN = false;
    bf16* U;
    __device__ __forceinline__ void operator()(const f32x4 (&acc)[2][2][4][2], const Unit& u, int wr, int wc, int fr, int fq) const {
        EPI_ROWS_BEGIN
            bf16* rp = U + (unsigned)(row * DFF + u.pn * 256 + wc * 32 + fq * 8);
#pragma unroll
            for (int bj = 0; bj < 2; ++bj) { f32x4 a0 = acc[ai][bj][m][0], a1 = acc[ai][bj][m][1];
#pragma unroll
                for (int j = 0; j < 4; ++j) { a0[j] = fmaxf(a0[j], 0.f); a1[j] = fmaxf(a1[j], 0.f); }
                a0 = a0 * a0; a1 = a1 * a1;
                *(u32x4*)(rp + bj * 128) = (u32x4){cvtpk(a0[0], a0[1]), cvtpk(a0[2], a0[3]), cvtpk(a1[0], a1[1]), cvtpk(a1[2], a1[3])}; }
        EPI_ROWS_END
    }
};

constexpr int TAIL_PM0 = 128, TAIL_ROW0 = TAIL_PM0 * 256, NSPLIT = 4;
struct EpiPart {
    static constexpr bool PERM = true, AFTER_DRAIN = false;
    float* PART; int ktper;
    __device__ __forceinline__ void operator()(const f32x4 (&acc)[2][2][4][2], const Unit& u, int wr, int wc, int fr, int fq) const {
        float* slab = PART + (size_t)(u.kt0 / ktper) * (1024 * 1024);
        EPI_ROWS_BEGIN
            float* rp = slab + (unsigned)((row - TAIL_ROW0) * DM + u.pn * 256 + wc * 32 + fq * 8);
#pragma unroll
            for (int bj = 0; bj < 2; ++bj) { f32x4* q = (f32x4*)(rp + bj * 128); q[0] = acc[ai][bj][m][0]; q[1] = acc[ai][bj][m][1]; }
        EPI_ROWS_END
    }
};
struct TailOrder {
    int G, c, ktper;
    __device__ bool next(int i, Unit& u) const { const int Lx = i * G + c; if (Lx >= 16 * NSPLIT) return false; const int tile = Lx / NSPLIT, ks = Lx % NSPLIT;
        u.pm = TAIL_PM0 + (tile >> 2); u.pn = tile & 3; u.kt0 = ks * ktper; return true; }
    __device__ __forceinline__ void a_ready(const Unit&) const {}
    __device__ __forceinline__ void done(const Unit&) const {}
};

namespace att {
constexpr int KBUF = 64 * 208, VBUF = 128 * 144, OFF_K = 0, OFF_V = 2 * KBUF, OFF_WS = OFF_V + 2 * VBUF, OFF_UNIT = OFF_WS + 8 * 256, OFF_ST = OFF_UNIT + 256, STROW = 144;
__device__ __forceinline__ int crow(int r, int hi) { return (r & 3) + 8 * (r >> 2) + 4 * hi; }
#define MFMA32(a, b, c) __builtin_amdgcn_mfma_f32_32x32x16_bf16((a), (b), (c), 0, 0, 0)


__device__ __forceinline__ void pack4(const f32x16& p0, const f32x16& p1, u32x4 (&pf)[4]) {
    pf[0] = (u32x4){cvtpk(p0[0], p0[1]), cvtpk(p0[2], p0[3]), cvtpk(p0[4], p0[5]), cvtpk(p0[6], p0[7])};
    pf[1] = (u32x4){cvtpk(p0[8], p0[9]), cvtpk(p0[10], p0[11]), cvtpk(p0[12], p0[13]), cvtpk(p0[14], p0[15])};
    pf[2] = (u32x4){cvtpk(p1[0], p1[1]), cvtpk(p1[2], p1[3]), cvtpk(p1[4], p1[5]), cvtpk(p1[6], p1[7])};
    pf[3] = (u32x4){cvtpk(p1[8], p1[9]), cvtpk(p1[10], p1[11]), cvtpk(p1[12], p1[13]), cvtpk(p1[14], p1[15])};
}
template <bool MASK>
__device__ __forceinline__ void sb_sub(const f32x16& p, int keybase, int tq, int hi, float& carry, u32x4& f0, u32x4& f1) {
    float kp[16], sg[16];
#pragma unroll
    for (int r = 0; r < 16; ++r) {
        const float e = ex2(p[r]); float kk = __builtin_amdgcn_rcpf(1.0f + e); float s_ = 1.0f - kk;
        if (MASK) { const int key = keybase + crow(r, hi); const bool ok = (key < tq) && (key >= NPAD); kk = ok ? kk : 1.0f; s_ = ok ? s_ : 0.f; }
        kp[r] = kk; sg[r] = s_;
    }
    float G[4], Gp[4], GG[4];
#pragma unroll
    for (int q = 0; q < 4; ++q) { G[q] = (kp[4 * q] * kp[4 * q + 1]) * (kp[4 * q + 2] * kp[4 * q + 3]);
        const auto rr = __builtin_amdgcn_permlane32_swap(__float_as_uint(G[q]), __float_as_uint(G[q]), false, false);
        Gp[q] = __uint_as_float(rr[1]); GG[q] = __uint_as_float(rr[0]) * __uint_as_float(rr[1]); }
    float T[4]; T[3] = 1.0f; T[2] = GG[3]; T[1] = GG[3] * GG[2]; T[0] = T[1] * GG[1];
    float w[16];
#pragma unroll
    for (int q = 0; q < 4; ++q) {
        const float base = carry * T[q] * (hi == 0 ? Gp[q] : 1.0f);
        const float e3 = base, e2 = e3 * kp[4 * q + 3], e1 = e2 * kp[4 * q + 2], e0 = e1 * kp[4 * q + 1];
        w[4 * q + 3] = sg[4 * q + 3] * e3; w[4 * q + 2] = sg[4 * q + 2] * e2; w[4 * q + 1] = sg[4 * q + 1] * e1; w[4 * q] = sg[4 * q] * e0;
    }
    carry *= T[0] * GG[0];
    f0 = (u32x4){cvtpk(w[0], w[1]), cvtpk(w[2], w[3]), cvtpk(w[4], w[5]), cvtpk(w[6], w[7])};
    f1 = (u32x4){cvtpk(w[8], w[9]), cvtpk(w[10], w[11]), cvtpk(w[12], w[13]), cvtpk(w[14], w[15])};
}
template <int KIND>
__device__ __forceinline__ void unit(const Ptrs& P, int bh, int u, LAS unsigned char* lds, bool do_store) {
    constexpr int DQK = (KIND == 1) ? 96 : 64, DV = (KIND == 2) ? 128 : 64, NH = (KIND == 2) ? 4 : 8, KROW = DQK * 2 + 16, VROW = 144, NQF = DQK / 16, NDB = DV / 32;
    int tid_l = threadIdx.x; asm volatile("" : "+v"(tid_l));
    const int tid = tid_l, lane = tid & 63, r32 = lane & 31, hi = lane >> 5, wid = __builtin_amdgcn_readfirstlane(tid >> 6);
    const int b = bh / NH, h = bh % NH;
    const int q0 = (u == 0) ? 0 : 128 + 256 * (u - 1), nrows = (u == 0) ? 128 : 256, ktmax = (u == 0) ? 1 : 4 * u + 1;
    const size_t rowb = (size_t)b * LSEQ;
    const bool active = (32 * wid < nrows);
    const int q0w = q0 + 32 * wid, tq = q0w + r32, ktw = (q0w + 31) >> 6;
    const bf16* Qb; int ldq; const bf16* Kb; int ldk; const bf16* VT;
    if (KIND == 0) { Qb = P.MIX + h * 64; ldq = DMIX; Kb = P.KSB + h * 64; ldk = 512; VT = P.VTSB; }
    else if (KIND == 1) { Qb = P.MIX + 512 + h * 64; ldq = DMIX; Kb = P.KN + h * 64; ldk = 512; VT = P.VTMLA; }
    else { Qb = P.RQ + h * 64; ldq = 256; Kb = P.RK + h * 64; ldk = 256; VT = P.RVT; }
    VT += (size_t)bh * DV * LSEQ;
    bf16x8 qf[NQF];
#pragma unroll
    for (int d0 = 0; d0 < NQF; ++d0) qf[d0] = (bf16x8){0, 0, 0, 0, 0, 0, 0, 0};
    if (active) {
#pragma unroll
        for (int d0 = 0; d0 < 4; ++d0) qf[d0] = *(const bf16x8*)(Qb + (rowb + tq) * ldq + 16 * d0 + 8 * hi);
        if (KIND == 1) {
#pragma unroll
            for (int d0 = 0; d0 < 2; ++d0) qf[(KIND == 1) ? 4 + d0 : 0] = *(const bf16x8*)(P.QR + (rowb + tq) * 256 + h * 32 + 16 * d0 + 8 * hi);
        }
    }
    f32x16 o[NDB];
#pragma unroll
    for (int d = 0; d < NDB; ++d) o[d] = (f32x16){0.f, 0.f, 0.f, 0.f, 0.f, 0.f, 0.f, 0.f, 0.f, 0.f, 0.f, 0.f, 0.f, 0.f, 0.f, 0.f};
    float carry = 1.0f, mrun = -1e30f, lrun = 0.f;
    LAS float* wsf = (LAS float*)(lds + OFF_WS) + wid * 64;
    u32x4 kreg, kreg2 = (u32x4){0u, 0u, 0u, 0u}, vreg[DV / 64];
    const int srow = tid >> 3, sch = tid & 7;
#define ATT_LOAD(kt_) do { const size_t key0_ = rowb + (size_t)64 * (kt_); \
        kreg = *(const u32x4*)(Kb + (key0_ + srow) * ldk + sch * 8); \
        if (KIND == 1 && tid < 256) kreg2 = *(const u32x4*)(P.KR + (key0_ + (tid >> 2)) * 32 + (tid & 3) * 8); \
        _Pragma("unroll") for (int i_ = 0; i_ < DV / 64; ++i_) vreg[i_] = *(const u32x4*)(VT + (size_t)(srow + 64 * i_) * LSEQ + 64 * (kt_) + sch * 8); } while (0)
#define ATT_WRITE(buf_) do { LAS unsigned char* kb_ = lds + OFF_K + (buf_) * KBUF; LAS unsigned char* vb_ = lds + OFF_V + (buf_) * VBUF; \
        *(LAS u32x4*)(kb_ + srow * KROW + sch * 16) = kreg; \
        if (KIND == 1 && tid < 256) *(LAS u32x4*)(kb_ + (tid >> 2) * KROW + 128 + (tid & 3) * 16) = kreg2; \
        _Pragma("unroll") for (int i_ = 0; i_ < DV / 64; ++i_) { LAS unsigned char* q_ = vb_ + (srow + 64 * i_) * VROW + (sch >> 1) * 32 + (sch & 1) * 8; \
            *(LAS u32x2*)q_ = (u32x2){vreg[i_].x, vreg[i_].y}; *(LAS u32x2*)(q_ + 16) = (u32x2){vreg[i_].z, vreg[i_].w}; } } while (0)

    int ktmin = 1;
    if (KIND == 2 && u >= 1) {
        ktmin = q0 >> 6;
        const float g256 = ex2(256.0f * ret_lg(h));
        const int e_ = tid >> 2, dseg = (tid & 3) * 16;
        const float* dp = P.DT + ((size_t)bh * 16 * 128 + e_) * 64 + dseg;
        f32x4 sacc[4];
#pragma unroll
        for (int c_ = 0; c_ < 4; ++c_) sacc[c_] = (f32x4){0.f, 0.f, 0.f, 0.f};
        int blk = 0;
        for (; blk + 4 <= u; blk += 4) {
            f32x4 ld_[4][4];
#pragma unroll
            for (int i_ = 0; i_ < 4; ++i_)
#pragma unroll
                for (int c_ = 0; c_ < 4; ++c_) ld_[i_][c_] = *(const f32x4*)(dp + (size_t)(blk + i_) * 128 * 64 + 4 * c_);
#pragma unroll
            for (int i_ = 0; i_ < 4; ++i_)
#pragma unroll
                for (int c_ = 0; c_ < 4; ++c_) sacc[c_] = sacc[c_] * g256 + ld_[i_][c_];
        }
        for (; blk < u; ++blk) {
#pragma unroll
            for (int c_ = 0; c_ < 4; ++c_) sacc[c_] = sacc[c_] * g256 + *(const f32x4*)(dp + (size_t)blk * 128 * 64 + 4 * c_);
        }
        LAS unsigned char* stp = lds + OFF_ST + e_ * STROW + dseg * 2;
        *(LAS u32x4*)stp = (u32x4){cvtpk(sacc[0][0], sacc[0][1]), cvtpk(sacc[0][2], sacc[0][3]), cvtpk(sacc[1][0], sacc[1][1]), cvtpk(sacc[1][2], sacc[1][3])};
        *(LAS u32x4*)(stp + 16) = (u32x4){cvtpk(sacc[2][0], sacc[2][1]), cvtpk(sacc[2][2], sacc[2][3]), cvtpk(sacc[3][0], sacc[3][1]), cvtpk(sacc[3][2], sacc[3][3])};
        __syncthreads();
        if (active) {
#pragma unroll
            for (int s_ = 0; s_ < 4; ++s_)
#pragma unroll
                for (int d = 0; d < NDB; ++d) {
                    const bf16x8 sf = *(const LAS bf16x8*)(lds + OFF_ST + (32 * d + r32) * STROW + (16 * s_ + 8 * hi) * 2);
                    o[d] = MFMA32(qf[s_], sf, o[d]);
                }
            const float gw_ = ex2((float)(32 * wid) * ret_lg(h));
#pragma unroll
            for (int d = 0; d < NDB; ++d)
#pragma unroll
                for (int r = 0; r < 16; ++r) o[d][r] *= gw_;
        }
    }
    int buf = 0;
    ATT_LOAD(ktmax); ATT_WRITE(0);
    __syncthreads();
    for (int kt = ktmax; kt >= ktmin; --kt) {
        if (kt > ktmin) ATT_LOAD(kt - 1);
        if (active && kt <= ktw) {
            const LAS unsigned char* Kt = lds + OFF_K + buf * KBUF; const LAS unsigned char* Vt = lds + OFF_V + buf * VBUF;
            f32x16 p0 = (f32x16){0.f, 0.f, 0.f, 0.f, 0.f, 0.f, 0.f, 0.f, 0.f, 0.f, 0.f, 0.f, 0.f, 0.f, 0.f, 0.f}, p1 = p0;
            {
                bf16x8 kfa[NQF], kfb[NQF];
#pragma unroll
                for (int d0 = 0; d0 < NQF; ++d0) { kfa[d0] = *(const LAS bf16x8*)(Kt + r32 * KROW + (16 * d0 + 8 * hi) * 2); kfb[d0] = *(const LAS bf16x8*)(Kt + (32 + r32) * KROW + (16 * d0 + 8 * hi) * 2); }
#pragma unroll
                for (int d0 = 0; d0 < NQF; ++d0) { p0 = MFMA32(kfa[d0], qf[d0], p0); p1 = MFMA32(kfb[d0], qf[d0], p1); }
            }
            bf16x8 vfr[(NDB == 2) ? 8 : 1];
            if (NDB == 2) {
#pragma unroll
                for (int ks = 0; ks < 4; ++ks)
#pragma unroll
                    for (int d = 0; d < 2; ++d) vfr[(NDB == 2) ? 2 * ks + d : 0] = *(const LAS bf16x8*)(Vt + (32 * d + r32) * VROW + (16 * ks + 8 * hi) * 2);
            }
            const int k0key = 64 * kt;
            const bool needmask = (k0key + 63 >= q0w) || (kt == 1);
            u32x4 pf[4];
            if (KIND == 0) {
                if (needmask) { sb_sub<true>(p1, k0key + 32, tq, hi, carry, pf[2], pf[3]); sb_sub<true>(p0, k0key, tq, hi, carry, pf[0], pf[1]); }
                else { sb_sub<false>(p1, k0key + 32, tq, hi, carry, pf[2], pf[3]); sb_sub<false>(p0, k0key, tq, hi, carry, pf[0], pf[1]); }
            } else if (KIND == 1) {
                if (needmask) {
#pragma unroll
                    for (int r = 0; r < 16; ++r) { const int key = k0key + crow(r, hi);
                        if (!((key <= tq) && (key >= NPAD))) p0[r] = -1e30f;
                        if (!((key + 32 <= tq) && (key + 32 >= NPAD))) p1[r] = -1e30f; }
                    asm volatile("" : "+v"(p0), "+v"(p1));
                }
                float mx = fmaxf(p0[0], p1[0]);
#pragma unroll
                for (int r = 1; r < 16; ++r) mx = fmaxf(mx, fmaxf(p0[r], p1[r]));
                { const auto rr = __builtin_amdgcn_permlane32_swap(__float_as_uint(mx), __float_as_uint(mx), false, false); mx = fmaxf(__uint_as_float(rr[0]), __uint_as_float(rr[1])); }
                const float mnew = fmaxf(mrun, mx);
                if (__any(mnew > mrun)) {
                    const float alpha = ex2(mrun - mnew); lrun *= alpha;
                    if (hi == 0) wsf[r32] = alpha;
                    asm volatile("s_waitcnt lgkmcnt(0)" ::: "memory");
#pragma unroll
                    for (int r = 0; r < 16; ++r) { const float a = wsf[crow(r, hi)];
#pragma unroll
                        for (int d = 0; d < NDB; ++d) o[d][r] *= a; }
                    asm volatile("s_waitcnt lgkmcnt(0)" ::: "memory");
                }
                mrun = mnew;
                float ls = 0.f;
#pragma unroll
                for (int r = 0; r < 16; ++r) { p0[r] = ex2(p0[r] - mrun); p1[r] = ex2(p1[r] - mrun); ls += p0[r] + p1[r]; }
                lrun += ls;
                pack4(p0, p1, pf);
            } else {
                const float cdec = ex2((float)(q0w - k0key) * ret_lg(h));
#pragma unroll
                for (int r = 0; r < 16; ++r) { p0[r] *= cdec; p1[r] *= cdec; }
                if (needmask) {
#pragma unroll
                    for (int r = 0; r < 16; ++r) { const int key = k0key + crow(r, hi); if (key > tq) p0[r] = 0.f; if (key + 32 > tq) p1[r] = 0.f; }
                    asm volatile("" : "+v"(p0), "+v"(p1));
                }
                pack4(p0, p1, pf);
            }
#pragma unroll
            for (int ks = 0; ks < 4; ++ks) {
                const bf16x8 pa = __builtin_bit_cast(bf16x8, pf[ks]);
#pragma unroll
                for (int d = 0; d < NDB; ++d) {
                    const bf16x8 vf = (NDB == 2) ? vfr[(NDB == 2) ? 2 * ks + d : 0] : *(const LAS bf16x8*)(Vt + (32 * d + r32) * VROW + (16 * ks + 8 * hi) * 2);
                    o[d] = MFMA32(pa, vf, o[d]);
                }
            }
        }
        if (kt > ktmin) ATT_WRITE(buf ^ 1);
        __syncthreads();
        buf ^= 1;
    }
#undef ATT_LOAD
#undef ATT_WRITE
    if (active && do_store) {
        if (KIND == 0) {
#pragma unroll
            for (int r = 0; r < 16; ++r) { bf16* q = P.MIX + (rowb + q0w + crow(r, hi)) * DMIX + h * 64 + r32;
#pragma unroll
                for (int d = 0; d < NDB; ++d) q[32 * d] = (bf16)f2bf(o[d][r]); }
        } else if (KIND == 1) {
            const float lt = lrun + __shfl_xor(lrun, 32);
            if (hi == 0) wsf[r32] = lt;
            asm volatile("s_waitcnt lgkmcnt(0)" ::: "memory");
#pragma unroll
            for (int r = 0; r < 16; ++r) { const float l_ = wsf[crow(r, hi)]; const float inv = l_ > 0.f ? 1.0f / l_ : 0.f;
                bf16* q = P.MIX + (rowb + q0w + crow(r, hi)) * DMIX + 512 + h * 64 + r32;
#pragma unroll
                for (int d = 0; d < NDB; ++d) q[32 * d] = (bf16)f2bf(o[d][r] * inv); }
            asm volatile("s_waitcnt lgkmcnt(0)" ::: "memory");
        } else {
#pragma unroll
            for (int r = 0; r < 16; ++r) {
                float s = 0.f;
#pragma unroll
                for (int d = 0; d < NDB; ++d) s += o[d][r];
#pragma unroll
                for (int x = 1; x < 32; x <<= 1) s += __shfl_xor(s, x);
                const float mean = s * (1.0f / 128.0f); float q2 = 0.f;
#pragma unroll
                for (int d = 0; d < NDB; ++d) { const float dd = o[d][r] - mean; q2 += dd * dd; }
#pragma unroll
                for (int x = 1; x < 32; x <<= 1) q2 += __shfl_xor(q2, x);
                const float rstd = 1.0f / sqrtf(q2 * (1.0f / 128.0f) + LN_EPS);
                bf16* q = P.MIX + (rowb + q0w + crow(r, hi)) * DMIX + 1024 + h * 128 + r32;
#pragma unroll
                for (int d = 0; d < NDB; ++d) { const float g = bf2f(q[32 * d]); const float sl = g / (1.0f + ex2(-g * 1.4426950408889634f));
                    q[32 * d] = (bf16)f2bf(sl * (o[d][r] - mean) * rstd); }
            }
        }
    }
}
__device__ __forceinline__ void ret_state_jobs(const Ptrs& P) {
    int tid_l = threadIdx.x; asm volatile("" : "+v"(tid_l));
    const int lane = tid_l & 63, r32 = lane & 31, hi = lane >> 5, wid = __builtin_amdgcn_readfirstlane(tid_l >> 6), eb = wid >> 1, db = wid & 1;
    for (int job = blockIdx.x; job < 32 * 16; job += gridDim.x) {
        const int bh = job >> 4, blk = job & 15, h = bh & 3;
        const int key0 = blk == 0 ? 0 : 128 + 256 * (blk - 1), ntile = blk == 0 ? 2 : 4;
        const float g64 = ex2(64.0f * ret_lg(h));
        const bf16* va = P.RVT + ((size_t)bh * 128 + 32 * eb + r32) * LSEQ + key0 + 8 * hi;
        const bf16* kb = P.RKT + ((size_t)bh * 64 + 32 * db + r32) * LSEQ + key0 + 8 * hi;
        f32x16 acc = (f32x16){0.f, 0.f, 0.f, 0.f, 0.f, 0.f, 0.f, 0.f, 0.f, 0.f, 0.f, 0.f, 0.f, 0.f, 0.f, 0.f};
        for (int j = 0; j < ntile; ++j) {
            bf16x8 af[4], bfr[4];
#pragma unroll
            for (int s_ = 0; s_ < 4; ++s_) { af[s_] = *(const bf16x8*)(va + 64 * j + 16 * s_); bfr[s_] = *(const bf16x8*)(kb + 64 * j + 16 * s_); }
#pragma unroll
            for (int s_ = 0; s_ < 4; ++s_) acc = MFMA32(af[s_], bfr[s_], acc);
#pragma unroll
            for (int r = 0; r < 16; ++r) acc[r] *= g64;
        }
        float* dst = P.DT + ((size_t)job * 128 + 32 * eb) * 64 + 32 * db + r32;
#pragma unroll
        for (int r = 0; r < 16; ++r) dst[crow(r, hi) * 64] = acc[r];
    }
}
constexpr int UNITS_PER_LEVEL = 64 + 64 + 32, NUNITS = 17 * UNITS_PER_LEVEL;
__device__ __forceinline__ void phase(const Ptrs& P, LAS unsigned char* lds, unsigned* counter, bool do_store) {
    volatile LAS int* ubox = (volatile LAS int*)(lds + OFF_UNIT);
    for (;;) {
        if (threadIdx.x == 0) ubox[0] = (int)atomicAdd(counter, 1u);
        __syncthreads();
        const int i = __builtin_amdgcn_readfirstlane(ubox[0]);
        __syncthreads();
        if (i >= NUNITS) break;
        const int lvl = i / UNITS_PER_LEVEL, j = i % UNITS_PER_LEVEL, u = 16 - lvl;
        if (j < 64) unit<1>(P, j, u, lds, do_store);
        else if (j < 128) unit<0>(P, j - 64, u, lds, do_store);
        else unit<2>(P, j - 128, u, lds, do_store);
    }
}
}

template <int MODE>
__device__ __forceinline__ void colmap(int p, int& src, float& sc) {
    sc = 1.f; src = p;
    if (MODE == 1) {
        if (p < 1536) { if (p < 512) sc = 0.18033688011112042f; }
        else if (p < 2048) { const int c = (p - 1536) & 255, isk = (p >= 1792), bj = c >> 7, wc = (c >> 5) & 3, n = (c >> 4) & 1, i = c & 15;
            src = (isk ? 2464 : 2208) + 64 * (2 * bj + (wc >> 1)) + 32 * n + 16 * (wc & 1) + i; if (isk) sc = 0.125f; }
        else if (p < 2560) src = 2720 + (p - 2048);
        else if (p < 3072) src = 3232 + (p - 2560);
        else if (p < 3328) src = 1920 + (p - 3072);
        else if (p < 3712) src = 1536 + (p - 3328);
        else if (p < 3744) src = 2176 + (p - 3712);
        else src = -1;
    } else if (MODE == 2) {
        sc = 0.14724444602590306f;
        if (p < 512) src = (p >> 6) * 96 + (p & 63); else { const int q = p - 512; src = (q >> 5) * 96 + 64 + (q & 31); }
    } else if (MODE == 3) {
        if (p < 512) src = (p >> 6) * 128 + (p & 63); else { const int q = p - 512; src = (q >> 6) * 128 + 64 + (q & 63); }
    }
}
template <int MODE>
__device__ __forceinline__ void conv_item(const float* W, int K, int Nsrc, int Nphys, const float* gain, bf16* WT, LAS float* scr, int item, int lane) {
    const int nblk = Nphys / 32, kb = item / nblk, nb = item % nblk, k0 = 64 * kb, n0 = 32 * nb;
    int src; float sc; colmap<MODE>(n0 + (lane & 31), src, sc);
#pragma unroll 8
    for (int i = 0; i < 32; ++i) { const int kk = 2 * i + (lane >> 5); float v = 0.f;
        if (src >= 0) { v = W[(size_t)(k0 + kk) * Nsrc + src] * sc; if (gain) v *= gain[k0 + kk]; }
        scr[kk * 33 + (lane & 31)] = v; }
    asm volatile("s_waitcnt lgkmcnt(0)" ::: "memory");
    const int c = lane & 7;
#pragma unroll
    for (int j = 0; j < 4; ++j) { const int n = (lane >> 3) + 8 * j; const LAS float* s = scr + (8 * c) * 33 + n;
        u32x4 o; o.x = cvtpk(s[0 * 33], s[1 * 33]); o.y = cvtpk(s[2 * 33], s[3 * 33]); o.z = cvtpk(s[4 * 33], s[5 * 33]); o.w = cvtpk(s[6 * 33], s[7 * 33]);
        *(u32x4*)(WT + (size_t)(n0 + n) * K + k0 + 8 * c) = o; }
    asm volatile("s_waitcnt lgkmcnt(0)" ::: "memory");
}
__device__ __forceinline__ void convert_weights(const Ptrs& P, int layer, LAS unsigned char* lds, int gw, int NGW, int wave, int lane) {
    LAS float* scr = (LAS float*)(lds + wave * 16384);
    constexpr int I_IN = 16 * (NIN / 32), I_UQ = 6 * 24, I_UKV = 4 * 32, I_OUT = 24 * 32, I_1 = 16 * 128, I_2 = 64 * 32, NIT = I_IN + I_UQ + I_UKV + I_OUT + I_1 + I_2;
    const float* w_in = P.in[4] + (size_t)layer * 1024 * NIN_LOG; const float* gq = P.in[5] + layer * 384; const float* gkv = P.in[6] + layer * 256;
    const float* w_uq = P.in[7] + (size_t)layer * 384 * 768; const float* w_ukv = P.in[8] + (size_t)layer * 256 * 1024; const float* w_out = P.in[9] + (size_t)layer * 1536 * 1024;
    const float* w1 = P.in[12] + (size_t)layer * 1024 * 4096; const float* w2 = P.in[13] + (size_t)layer * 4096 * 1024;
    for (int it = gw; it < NIT; it += NGW) {
        int r = it;
        if (r < I_IN) { conv_item<1>(w_in, 1024, NIN_LOG, NIN, nullptr, P.Win, scr, r, lane); continue; } r -= I_IN;
        if (r < I_UQ) { conv_item<2>(w_uq, 384, 768, 768, gq, P.Wuq, scr, r, lane); continue; } r -= I_UQ;
        if (r < I_UKV) { conv_item<3>(w_ukv, 256, 1024, 1024, gkv, P.Wukv, scr, r, lane); continue; } r -= I_UKV;
        if (r < I_OUT) { conv_item<0>(w_out, 1536, 1024, 1024, nullptr, P.Wout, scr, r, lane); continue; } r -= I_OUT;
        if (r < I_1) { conv_item<0>(w1, 1024, 4096, 4096, nullptr, P.W1, scr, r, lane); continue; } r -= I_1;
        conv_item<0>(w2, 4096, 1024, 1024, nullptr, P.W2, scr, r, lane);
    }
}
__device__ __forceinline__ void ln_regs(f32x4 (&v)[4], const float* g, const float* bta, int lane) {
    float s = 0.f;
#pragma unroll
    for (int j = 0; j < 4; ++j) s += (v[j][0] + v[j][1]) + (v[j][2] + v[j][3]);
    const float mean = wave_sum(s) * (1.f / DM); float s2 = 0.f;
#pragma unroll
    for (int j = 0; j < 4; ++j) { v[j] = v[j] - mean; s2 += (v[j][0] * v[j][0] + v[j][1] * v[j][1]) + (v[j][2] * v[j][2] + v[j][3] * v[j][3]); }
    const float rstd = 1.f / sqrtf(wave_sum(s2) * (1.f / DM) + LN_EPS);
#pragma unroll
    for (int j = 0; j < 4; ++j) { const f32x4 gg = ((const f32x4*)g)[64 * j + lane], bb = ((const f32x4*)bta)[64 * j + lane]; v[j] = v[j] * rstd * gg + bb; }
}
__device__ __forceinline__ void store_h_hb(const Ptrs& P, int row, const f32x4 (&v)[4], int lane, bool write_h) {
#pragma unroll
    for (int j = 0; j < 4; ++j) {
        if (write_h) ((f32x4*)(P.H + (size_t)row * DM))[64 * j + lane] = v[j];
        u32x2 w; w.x = cvtpk(v[j][0], v[j][1]); w.y = cvtpk(v[j][2], v[j][3]); ((u32x2*)(P.HB + (size_t)row * DM))[64 * j + lane] = w; }
}
__device__ __forceinline__ void phase_prep(const Ptrs& P, LAS unsigned char* lds, int gw, int NGW, int wave, int lane) {
    convert_weights(P, 0, lds, gw, NGW, wave, lane);
    const int gt = gw * 64 + lane, NGT = NGW * 64;
    for (int i = gt; i < LSEQ * 48; i += NGT) {
        const int t = i / 48, k = i % 48; const float pos = (float)(t - NPAD);
        const float inv = (k < 32) ? ex2(-(float)k * (13.287712379549449f / 32.0f)) : ex2(-(float)(k - 32) * (13.287712379549449f / 16.0f));
        const float ang = pos * inv;
        double rev = (double)ang * 0.15915494309189535; rev -= floor(rev); const float fr = (float)rev;
        const f32x2 cs = {__builtin_amdgcn_cosf(fr), __builtin_amdgcn_sinf(fr)};
        if (k < 32) P.tab64[(size_t)t * 32 + k] = cs; else P.tab32[(size_t)t * 16 + (k - 32)] = cs;
    }
    const float* x = P.in[0]; const float* meta = P.in[1]; const float* g = P.in[2]; const float* bta = P.in[3];
    for (int row = gw; row < MROWS; row += NGW) {
        const int b = row / LSEQ, t = row - b * LSEQ; f32x4 v[4];
#pragma unroll
        for (int j = 0; j < 4; ++j) {
            if (t < NPAD) v[j] = (f32x4){0.f, 0.f, 0.f, 0.f};
            else if (t < 128) v[j] = ((const f32x4*)(meta + (size_t)(t - NPAD) * DM))[64 * j + lane];
            else v[j] = ((const f32x4*)(x + ((size_t)b * SEQ + (t - 128)) * DM))[64 * j + lane]; }
        ln_regs(v, g, bta, lane);
        store_h_hb(P, row, v, lane, true);
    }
}
__device__ __forceinline__ void ln_store(const Ptrs& P, int row, const f32x4 (&v)[4], int lane, bool final_out) {
    if (!final_out) store_h_hb(P, row, v, lane, true);
    else { const int b = row / LSEQ, t = row - b * LSEQ;
        if (t >= 128) {
#pragma unroll
            for (int j = 0; j < 4; ++j) ((f32x4*)(P.out + ((size_t)b * SEQ + (t - 128)) * DM))[64 * j + lane] = v[j]; } }
}
__device__ __forceinline__ void phase_ln(const Ptrs& P, const bf16* T, const float* g, const float* bta, bool final_out, int gw, int NGW, int lane) {
    int row = gw;
    for (; row + NGW < TAIL_ROW0; row += 2 * NGW) {
        f32x4 va[4], vb[4];
#pragma unroll
        for (int j = 0; j < 4; ++j) { va[j] = ((const f32x4*)(P.H + (size_t)row * DM))[64 * j + lane]; vb[j] = ((const f32x4*)(P.H + (size_t)(row + NGW) * DM))[64 * j + lane]; }
        if (T) {
#pragma unroll
            for (int j = 0; j < 4; ++j) { const u32x2 t0 = ((const u32x2*)(T + (size_t)row * DM))[64 * j + lane], t1 = ((const u32x2*)(T + (size_t)(row + NGW) * DM))[64 * j + lane];
                va[j] = va[j] * DN_ALPHA + (f32x4){__builtin_bit_cast(float, t0.x << 16), __builtin_bit_cast(float, t0.x & 0xffff0000u), __builtin_bit_cast(float, t0.y << 16), __builtin_bit_cast(float, t0.y & 0xffff0000u)};
                vb[j] = vb[j] * DN_ALPHA + (f32x4){__builtin_bit_cast(float, t1.x << 16), __builtin_bit_cast(float, t1.x & 0xffff0000u), __builtin_bit_cast(float, t1.y << 16), __builtin_bit_cast(float, t1.y & 0xffff0000u)}; }
        }
        ln_regs(va, g, bta, lane); ln_regs(vb, g, bta, lane);
        ln_store(P, row, va, lane, final_out); ln_store(P, row + NGW, vb, lane, final_out);
    }
    for (; row < MROWS; row += NGW) {
        f32x4 v[4];
#pragma unroll
        for (int j = 0; j < 4; ++j) v[j] = ((const f32x4*)(P.H + (size_t)row * DM))[64 * j + lane];
        if (row >= TAIL_ROW0) {
            const float* part = (const float*)(P.ws + WS_PART) + (size_t)(row - TAIL_ROW0) * DM;
#pragma unroll
            for (int j = 0; j < 4; ++j) { f32x4 sacc = ((const f32x4*)part)[64 * j + lane];
#pragma unroll
                for (int ks = 1; ks < NSPLIT; ++ks) sacc += ((const f32x4*)(part + (size_t)ks * 1024 * 1024))[64 * j + lane];
                v[j] = v[j] * DN_ALPHA + sacc; }
        }
        ln_regs(v, g, bta, lane);
        if (!final_out) store_h_hb(P, row, v, lane, true);
        else { const int b = row / LSEQ, t = row - b * LSEQ;
            if (t >= 128) {
#pragma unroll
                for (int j = 0; j < 4; ++j) ((f32x4*)(P.out + ((size_t)b * SEQ + (t - 128)) * DM))[64 * j + lane] = v[j]; } }
    }
}

#define XB_TMO      128
#define XB_XCNT(j)  (256  + 64 * (j))
#define XB_XSUB(j)  (1280 + 64 * (j))
#define XB_XGEN(j)  (2304 + 64 * (j))
#define XB_TOP      3328
#define XB_TOPGEN   3392
#define XCD_BAR_WORDS 3456
#define XB_SPIN_CAP (1u << 18)

__device__ __forceinline__ unsigned xb_ld(unsigned* p)              { return __hip_atomic_load(p, __ATOMIC_RELAXED, __HIP_MEMORY_SCOPE_AGENT); }
__device__ __forceinline__ unsigned xb_add(unsigned* p, unsigned v) { return __hip_atomic_fetch_add(p, v, __ATOMIC_RELAXED, __HIP_MEMORY_SCOPE_AGENT); }
__device__ __forceinline__ unsigned xb_xcc_id() { return (unsigned)__builtin_amdgcn_s_getreg((3 << 11) | 20) & 0xFu; }
#define XB_SPIN(cond, bar) do { unsigned _sp = 0; while (cond) { __builtin_amdgcn_s_sleep(1); \
    if ((++_sp & 255u) == 0u) { if (xb_ld(&(bar)[XB_TMO])) break; if (_sp > XB_SPIN_CAP) { atomicAdd(&(bar)[XB_TMO], 1u); break; } } } } while (0)

struct XcdBarrier {
    unsigned* bar; unsigned x;
    volatile LAS unsigned* st;
};

__device__ __forceinline__ XcdBarrier xcd_barrier_post(unsigned* bar, volatile LAS unsigned* st) {
    XcdBarrier b; b.bar = bar; b.x = xb_xcc_id(); b.st = st;
    if (threadIdx.x == 0) (void)xb_add(&bar[XB_XCNT(b.x)], 1u);
    return b;
}
__device__ __forceinline__ void xcd_barrier_complete(unsigned* bar, unsigned x, unsigned& nloc, unsigned& nx) {
    const unsigned G = gridDim.x * gridDim.y * gridDim.z;
    unsigned sum, cnt, mine, sp = 0u;
    for (;;) {
        sum = 0u; cnt = 0u; mine = 0u;
#pragma unroll
        for (unsigned j = 0; j < 16; ++j) { const unsigned c = xb_ld(&bar[XB_XCNT(j)]); sum += c; cnt += (c > 0u) ? 1u : 0u; mine = (j == x) ? c : mine; }
        if (sum == G) break;
        __builtin_amdgcn_s_sleep(1);
        if ((++sp & 255u) == 0u) { if (xb_ld(&bar[XB_TMO])) break; if (sp > XB_SPIN_CAP) { atomicAdd(&bar[XB_TMO], 1u); break; } }
    }
    nloc = mine > 0u ? mine : 1u; nx = cnt > 0u ? cnt : 1u;
}

__device__ __forceinline__ void xcd_barrier(const XcdBarrier& b) {
    asm volatile("s_waitcnt vmcnt(0)" ::: "memory");
    __syncthreads();
    if (threadIdx.x == 0) {
        unsigned* bar = b.bar;
        __builtin_amdgcn_s_waitcnt(0);
        unsigned nloc = b.st[0], nx = b.st[1];
        if (nloc == 0u) { xcd_barrier_complete(bar, b.x, nloc, nx); b.st[0] = nloc; b.st[1] = nx; }
        const unsigned old = xb_add(&bar[XB_XSUB(b.x)], 1u);
        const unsigned gen = old / nloc;
        if (old + 1u == (gen + 1u) * nloc) {
            __builtin_amdgcn_fence(__ATOMIC_RELEASE, "agent");
            asm volatile("s_waitcnt vmcnt(0)" ::: "memory");
            const unsigned og = xb_add(&bar[XB_TOP], 1u);
            const unsigned tg = og / nx;
            if (og + 1u == (tg + 1u) * nx) xb_add(&bar[XB_TOPGEN], 1u);
            else XB_SPIN(xb_ld(&bar[XB_TOPGEN]) == tg, bar);
            __builtin_amdgcn_fence(__ATOMIC_ACQUIRE, "agent");
            xb_add(&bar[XB_XGEN(b.x)], 1u);
            asm volatile("s_waitcnt vmcnt(0)" ::: "memory");
        } else {
            XB_SPIN(xb_ld(&bar[XB_XGEN(b.x)]) == gen, bar);
            __builtin_amdgcn_fence(__ATOMIC_ACQUIRE, "agent");
            asm volatile("s_waitcnt vmcnt(0)" ::: "memory");
        }
    }
    __syncthreads();
}

struct Args { const float* in[16]; float* out; unsigned char* ws; int ph_lo, ph_hi; };
static_assert(sizeof(Args) == 16 * 8 + 8 + 8 + 8, "Args has no padding");

template <class Epi>
__device__ __forceinline__ void run_gemm(LAS unsigned char* lds, const bf16* A, const bf16* Bt, int N, int K, const Epi& E, int rot = 0) {
    pg8::Gemm g{A, Bt, MROWS, N, K, K}; pg8::StaticOrder S; S.init(MROWS, N, (int)gridDim.x, ((int)blockIdx.x + rot) % (int)gridDim.x);
    pg8::gemm_phase<Epi, pg8::StaticOrder, true, true>(lds, g, S, E);
}
__device__ __forceinline__ void run_gemm_res(LAS unsigned char* lds, const bf16* A, const bf16* Bt, int K, float* H, float* PART, bf16* T) {
    const int rot = ((int)blockIdx.x + 128) % (int)gridDim.x;
    { EpiPart E{PART, K / 64 / NSPLIT}; pg8::Gemm g{A, Bt, MROWS, 1024, K / NSPLIT, K}; TailOrder S{(int)gridDim.x, rot, K / 64 / NSPLIT};
      pg8::gemm_phase<EpiPart, TailOrder, true, true>(lds, g, S, E); }
    if (T) { EpiResT E{T}; pg8::Gemm g{A, Bt, TAIL_ROW0, 1024, K, K}; pg8::StaticOrder S; S.init(TAIL_ROW0, 1024, (int)gridDim.x, (int)blockIdx.x);
      pg8::gemm_phase<EpiResT, pg8::StaticOrder, true, true>(lds, g, S, E); }
    else { EpiRes E{H}; pg8::Gemm g{A, Bt, TAIL_ROW0, 1024, K, K}; pg8::StaticOrder S; S.init(TAIL_ROW0, 1024, (int)gridDim.x, (int)blockIdx.x);
      pg8::gemm_phase<EpiRes, pg8::StaticOrder, true, true>(lds, g, S, E); }
}

__global__ void __launch_bounds__(NTHREADS, 2) mk_fwd(Args a) {
    extern __shared__ __attribute__((aligned(16))) unsigned char lds_raw[];
    LAS unsigned char* lds = (LAS unsigned char*)lds_raw;
    volatile LAS unsigned* MISC = (volatile LAS unsigned*)(lds + 143360);
    if (threadIdx.x < 32) MISC[threadIdx.x] = 0u;
    __syncthreads();
    XcdBarrier xbar = xcd_barrier_post((unsigned*)(a.ws + WS_MISC + MISC_CTL) + 4096, MISC + 8);
    for (int ph = a.ph_lo; ph < a.ph_hi; ++ph) {
        int tid_l = threadIdx.x; asm volatile("" : "+v"(tid_l));
        const int tid = tid_l, lane = tid & 63, wave = __builtin_amdgcn_readfirstlane(tid >> 6);
        const int gw = (int)blockIdx.x * NWAVES + wave, NGW = (int)gridDim.x * NWAVES;
    size_t zoff = 0; asm volatile("" : "+s"(zoff));
    Ptrs P;
#pragma unroll
    for (int i = 0; i < 16; ++i) P.in[i] = a.in[i] + zoff;
    unsigned char* wsl = a.ws + zoff; float* outl = a.out + zoff;
    fill_ptrs(P, wsl, outl);
        if (ph == 0) phase_prep(P, lds, gw, NGW, wave, lane);
        else {
            const int l = (ph - 1) >> 3, s = (ph - 1) & 7;
            if (s == 0) {
#ifndef NO_IN
 EpiIn E{wsl, outl, l}; run_gemm(lds, P.HB, P.Win, NIN, 1024, E);
#endif
 }
            else if (s == 1) {
#ifndef NO_U
 { EpiUq E{wsl, outl, l}; run_gemm(lds, P.CQ, P.Wuq, 768, 384, E); } { EpiUkv E{wsl, outl, l}; run_gemm(lds, P.CKV, P.Wukv, 1024, 256, E, 104); }
 att::ret_state_jobs(P);
#endif
 }
            else if (s == 2) {
#ifndef NO_ATT
#ifdef PROBE_ATT
 const int nrep = 2 + (int)P.ctl[1];
#else
 const int nrep = 1;
#endif
 for (int rep = 0; rep < nrep; ++rep) att::phase(P, lds, P.ctl + 64 * (l + 1 + 8 * rep), rep == nrep - 1);
#endif
 }
            else if (s == 3) {
#ifndef NO_RES
 run_gemm_res(lds, P.MIX, P.Wout, 1536, P.H, (float*)(wsl + WS_PART), ((TMASK >> (2 * l)) & 1) ? P.HB : nullptr);
#endif
 }
            else if (s == 4) phase_ln(P, ((TMASK >> (2 * l)) & 1) ? P.HB : nullptr, P.in[10] + l * DM, P.in[11] + l * DM, false, gw, NGW, lane);
            else if (s == 5) {
#ifndef NO_FF
 EpiFf1 E{P.U};
#ifdef PROBE_FF1
 const int nrep1 = 2 + (int)P.ctl[1];
#else
 const int nrep1 = 1;
#endif
 for (int rep = 0; rep < nrep1; ++rep) run_gemm(lds, P.HB, P.W1, 4096, 1024, E);
#endif
 }
            else if (s == 6) {
#ifndef NO_RES
 run_gemm_res(lds, P.U, P.W2, 4096, P.H, (float*)(wsl + WS_PART), ((TMASK >> (2 * l + 1)) & 1) ? P.HB : nullptr);
#endif
 }
            else { if (l + 1 < DEPTH) convert_weights(P, l + 1, lds, gw, NGW, wave, lane);
                   phase_ln(P, ((TMASK >> (2 * l + 1)) & 1) ? P.HB : nullptr, P.in[14] + l * DM, P.in[15] + l * DM, l + 1 == DEPTH, gw, NGW, lane); }
        }
#ifndef T_NOSYNC
        if (ph + 1 < a.ph_hi) { if (ph == a.ph_lo) cg::this_grid().sync(); else xcd_barrier(xbar); }
#ifdef PROBE_SYNC
        if (ph + 1 < a.ph_hi) { cg::this_grid().sync(); cg::this_grid().sync(); }
#endif
#endif
    }
}

extern "C" void kernel_launch(void* const* d_in, const int* in_sizes, int n_in, void* d_out, int out_size, void* d_ws, size_t ws_size, hipStream_t stream) {
    static int grid = 0;
    if (grid == 0) {
        if (n_in != 16 || in_sizes[0] != BATCH * SEQ * DM || out_size != BATCH * SEQ * DM || ws_size < WS_END) {
            fprintf(stderr, "kernel_launch: unexpected shapes (n_in %d, in0 %d, out %d, ws %zu, need %zu); nothing launched\n", n_in, n_in > 0 ? in_sizes[0] : -1, out_size, ws_size, (size_t)WS_END); grid = -1; return; }
        int dev = 0, cus = 0, per_cu = 0;
        if (hipGetDevice(&dev) != hipSuccess || hipDeviceGetAttribute(&cus, hipDeviceAttributeMultiprocessorCount, dev) != hipSuccess) { grid = -1; return; }
        if (hipFuncSetAttribute((const void*)mk_fwd, hipFuncAttributeMaxDynamicSharedMemorySize, LDS_BYTES) != hipSuccess) { fprintf(stderr, "kernel_launch: hipFuncSetAttribute failed\n"); grid = -1; return; }
        if (hipOccupancyMaxActiveBlocksPerMultiprocessor(&per_cu, (const void*)mk_fwd, NTHREADS, LDS_BYTES) != hipSuccess || per_cu < 1) { fprintf(stderr, "kernel_launch: occupancy query says %d\n", per_cu); per_cu = 1; }
        (void)hipGetLastError();
        grid = cus * 1;
    }
    if (grid < 0) return;
    (void)hipMemsetAsync((char*)d_ws + WS_MISC + MISC_CTL, 0, CTL_BYTES, stream);
    Args a{};
    for (int i = 0; i < 16; ++i) a.in[i] = (const float*)d_in[i];
    a.out = (float*)d_out; a.ws = (unsigned char*)d_ws;
#if MK_SPLIT
    for (int ph = 0; ph < NPHASES; ++ph) { a.ph_lo = ph; a.ph_hi = ph + 1; hipLaunchKernelGGL(mk_fwd, dim3(grid), dim3(NTHREADS), LDS_BYTES, stream, a); }
#else
    a.ph_lo = 0; a.ph_hi = NPHASES;
    void* args[] = {&a};
    hipError_t e = hipLaunchCooperativeKernel((const void*)mk_fwd, dim3(grid), dim3(NTHREADS), args, LDS_BYTES, stream);
    if (e != hipSuccess) fprintf(stderr, "kernel_launch: cooperative launch failed: %s (grid %d)\n", hipGetErrorString(e), grid);
#endif
}
```

```cpp
#define TMASK 255
#include <hip/hip_runtime.h>
#include <hip/hip_cooperative_groups.h>
#include <cstdio>
#include <cstdint>
namespace cg = cooperative_groups;
#ifndef TMASK
#define TMASK 0
#endif
#ifndef MK_SPLIT
#define MK_SPLIT 0
#endif
namespace pg8 {
#define PG8_LAS __attribute__((address_space(3)))
typedef unsigned short bf16_t;
typedef short bf16x8 __attribute__((ext_vector_type(8)));
typedef float f32x4 __attribute__((ext_vector_type(4)));
typedef unsigned u32x4 __attribute__((ext_vector_type(4)));
constexpr int BM = 256, BK = 64, HALF = 128, HTB = HALF * BK * 2  , STAGE_BYTES = 8 * HTB, NXCD = 8, WGM = 8;

__host__ __device__ __forceinline__ int lds_byte(int r, int c) { const int st = (r >> 4) * 2 + (c >> 5), rr = r & 15, cc = c & 31, ob = rr * 64 + cc * 2; return st * 1024 + (ob ^ (((ob >> 9) & 1) << 5)); }
__host__ __device__ __forceinline__ void stage_rc(int b, int& R, int& C) { const int st = b / 1024, sb = b % 1024, swz = sb ^ (((sb >> 9) & 1) << 5); R = (st >> 1) * 16 + swz / 64; C = (st & 1) * 32 + (swz % 64) / 2; }
__host__ __device__ __forceinline__ int perm32(int rho) { const int n = rho >> 4, i = rho & 15; return 8 * (i >> 2) + 4 * n + (i & 3); }

struct Unit { int pm, pn, kt0; };
struct Gemm { const bf16_t* A; const bf16_t* Bt; int M, N, K, ld; };

struct StaticOrder {
    int nM, nN, nwg, G, c;
    __host__ __device__ void init(int M, int N, int G_, int c_) { nM = M / BM; nN = N / BM; nwg = nM * nN; G = G_; c = c_; }
    __host__ __device__ bool next(int i, Unit& u) const {
        const long L = (long)i * G + c; if (L >= nwg) return false;
        int wgid = (int)L; { const int q = nwg / NXCD, r = nwg % NXCD, xcd = wgid % NXCD, off = wgid / NXCD; wgid = (xcd < r ? xcd * (q + 1) : r * (q + 1) + (xcd - r) * q) + off; }
        const int nig = WGM * nN, gid = wgid / nig, fm = gid * WGM, gsz = (nM - fm) < WGM ? (nM - fm) : WGM;
        u.pm = fm + ((wgid % nig) % gsz); u.pn = (wgid % nig) / gsz; u.kt0 = 0; return true;
    }
    __device__ __forceinline__ void a_ready(const Unit&) const {}
    __device__ __forceinline__ void done(const Unit&) const {}
};
template <class Epi, class Sched, bool ALIGN_EPI = false, bool SP2 = false>
__device__ __forceinline__ void gemm_phase(PG8_LAS unsigned char* lds, const Gemm g, const Sched& S, const Epi& E) {
    int tid_l = threadIdx.x; asm volatile("" : "+v"(tid_l));
    const int tid = tid_l, wid = __builtin_amdgcn_readfirstlane(tid >> 6), lane = tid & 63, wr = wid >> 2, wc = wid & 3, fr = lane & 15, fq = lane >> 4;
    const int K = g.K, nt = K / BK;
    unsigned voffA[2], voffB[2];
#pragma unroll
    for (int i = 0; i < 2; ++i) { int R, C; stage_rc(tid * 16 + i * 8192, R, C); const int Rb = Epi::PERM ? ((R & ~31) + perm32(R & 31)) : R;
        voffA[i] = (unsigned)(R * g.ld + C) * 2u; voffB[i] = (unsigned)(Rb * g.ld + C) * 2u; }
    const size_t kstep = (size_t)(BK * 2);
    const size_t hstep = (size_t)HALF * g.ld * 2;
    const size_t tstep = 2 * hstep;
    const unsigned ldsw = (unsigned)wid * 1024u;
    const int aoff = lds_byte(wr * 64 + fr, fq * 8), boff = lds_byte(wc * 32 + fr, fq * 8);
#define PG8_SA(b, h) (((b) * 2 + (h)) * HTB)
#define PG8_SB(b, h) ((4 + (b) * 2 + (h)) * HTB)
#define PG8_STAGE(bufoff, gbase, voff) do { _Pragma("unroll") for (int _i = 0; _i < 2; ++_i) \
        __builtin_amdgcn_global_load_lds((const unsigned*)((const char*)(gbase) + (voff)[_i]), (PG8_LAS unsigned*)(lds + (bufoff) + ldsw + _i * 8192), 16, 0, 0); } while (0)
#define PG8_LDA(dst, b, h) do { _Pragma("unroll") for (int m = 0; m < 4; ++m) _Pragma("unroll") for (int k = 0; k < 2; ++k) dst[m][k] = *(const PG8_LAS bf16x8*)(lds + PG8_SA(b, h) + aoff + m * 2048 + k * 1024); } while (0)
#define PG8_LDB(dst, b, h) do { _Pragma("unroll") for (int n = 0; n < 2; ++n) _Pragma("unroll") for (int k = 0; k < 2; ++k) dst[n][k] = *(const PG8_LAS bf16x8*)(lds + PG8_SB(b, h) + boff + n * 2048 + k * 1024); } while (0)
#define PG8_MMA(ai, bj, At, Bt) do { __builtin_amdgcn_s_setprio(1); _Pragma("unroll") for (int m = 0; m < 4; ++m) _Pragma("unroll") for (int n = 0; n < 2; ++n) _Pragma("unroll") for (int k = 0; k < 2; ++k) \
        acc[ai][bj][m][n] = __builtin_amdgcn_mfma_f32_16x16x32_bf16(Bt[n][k], At[m][k], acc[ai][bj][m][n], 0, 0, 0); __builtin_amdgcn_s_setprio(0); } while (0)
#define PG8_WAIT_V(n) asm volatile("s_waitcnt vmcnt(" #n ")" ::: "memory")
#define PG8_WAIT_L(n) asm volatile("s_waitcnt lgkmcnt(" #n ")" ::: "memory")
#define PG8_BAR __builtin_amdgcn_s_barrier()
#define PG8_SCHED __builtin_amdgcn_sched_barrier(0)
    Unit cur, nxt; int ui = 0;
    if (!S.next(0, cur)) return;
    f32x4 acc[2][2][4][2];
#pragma unroll
    for (int a = 0; a < 2; ++a)
#pragma unroll
        for (int b = 0; b < 2; ++b)
#pragma unroll
            for (int m = 0; m < 4; ++m)
#pragma unroll
                for (int n = 0; n < 2; ++n) acc[a][b][m][n] = (f32x4){0.f, 0.f, 0.f, 0.f};
    bf16x8 At[4][2], B0[2][2], B1[2][2];
    const char* cA = (const char*)g.A + (size_t)cur.pm * tstep + (size_t)cur.kt0 * kstep; const char* cB = (const char*)g.Bt + (size_t)cur.pn * tstep + (size_t)cur.kt0 * kstep;
    S.a_ready(cur);
    if constexpr (SP2) {
        PG8_STAGE(PG8_SB(0, 0), cB, voffB); PG8_STAGE(PG8_SB(0, 1), cB + hstep, voffB); PG8_STAGE(PG8_SA(0, 0), cA, voffA); PG8_STAGE(PG8_SA(0, 1), cA + hstep, voffA);
        if (wr == 1) PG8_BAR;
        PG8_WAIT_V(2); PG8_BAR;
        PG8_STAGE(PG8_SB(1, 0), cB + kstep, voffB); PG8_STAGE(PG8_SA(1, 0), cA + kstep, voffA); PG8_STAGE(PG8_SB(1, 1), cB + hstep + kstep, voffB);
        PG8_WAIT_V(6); PG8_BAR;
    } else {
        PG8_STAGE(PG8_SB(0, 0), cB, voffB); PG8_STAGE(PG8_SA(0, 0), cA, voffA); PG8_STAGE(PG8_SB(0, 1), cB + hstep, voffB); PG8_STAGE(PG8_SA(0, 1), cA + hstep, voffA);
        if (wr == 1) PG8_BAR;
        PG8_WAIT_V(4); PG8_BAR;
        PG8_STAGE(PG8_SB(1, 0), cB + kstep, voffB); PG8_STAGE(PG8_SA(1, 0), cA + kstep, voffA); PG8_STAGE(PG8_SB(1, 1), cB + hstep + kstep, voffB);
        PG8_WAIT_V(6); PG8_BAR;
    }
    for (;;) {
        const bool has_next = S.next(ui + 1, nxt);
        const char* nA = has_next ? (const char*)g.A + (size_t)nxt.pm * tstep + (size_t)nxt.kt0 * kstep : cA; const char* nB = has_next ? (const char*)g.Bt + (size_t)nxt.pn * tstep + (size_t)nxt.kt0 * kstep : cB;
        for (int t = 0; t < nt; t += 2) {
            const bool last = (t == nt - 2);
            const char* a1 = cA + (size_t)(t + 1) * kstep;
            const char* a2 = last ? nA : cA + (size_t)(t + 2) * kstep; const char* b2 = last ? nB : cB + (size_t)(t + 2) * kstep;
            const char* a3 = a2 + kstep; const char* b3 = b2 + kstep;
            if (last && has_next) S.a_ready(nxt);
            if constexpr (SP2) {
            PG8_LDB(B0, 0, 0); PG8_LDB(B1, 0, 1); PG8_SCHED; PG8_LDA(At, 0, 0); PG8_STAGE(PG8_SA(1, 1), a1 + hstep, voffA);
            PG8_WAIT_V(8); PG8_WAIT_L(0); PG8_BAR; PG8_MMA(0, 0, At, B0); PG8_MMA(0, 1, At, B1); PG8_BAR; PG8_SCHED;
            PG8_LDA(At, 0, 1); PG8_STAGE(PG8_SB(0, 0), b2, voffB); PG8_STAGE(PG8_SB(0, 1), b2 + hstep, voffB); PG8_STAGE(PG8_SA(0, 0), a2, voffA);
            PG8_WAIT_V(8); PG8_WAIT_L(0); PG8_BAR; PG8_MMA(1, 0, At, B0); PG8_MMA(1, 1, At, B1); PG8_BAR; PG8_SCHED;
            PG8_LDB(B0, 1, 0); PG8_LDB(B1, 1, 1); PG8_SCHED; PG8_LDA(At, 1, 0); PG8_STAGE(PG8_SA(0, 1), a2 + hstep, voffA);
            PG8_WAIT_V(8); PG8_WAIT_L(0); PG8_BAR; PG8_MMA(0, 0, At, B0); PG8_MMA(0, 1, At, B1); PG8_BAR; PG8_SCHED;
            PG8_LDA(At, 1, 1); PG8_STAGE(PG8_SB(1, 0), b3, voffB); PG8_STAGE(PG8_SB(1, 1), b3 + hstep, voffB); PG8_STAGE(PG8_SA(1, 0), a3, voffA);
            PG8_WAIT_V(8); PG8_WAIT_L(0); PG8_BAR; PG8_MMA(1, 0, At, B0); PG8_MMA(1, 1, At, B1); PG8_BAR; PG8_SCHED;
            } else {
            PG8_LDB(B0, 0, 0); PG8_SCHED; PG8_LDA(At, 0, 0); PG8_STAGE(PG8_SA(1, 1), a1 + hstep, voffA);
            PG8_WAIT_L(8); PG8_BAR; PG8_WAIT_L(0); PG8_MMA(0, 0, At, B0); PG8_BAR; PG8_SCHED;
            PG8_LDB(B1, 0, 1); PG8_STAGE(PG8_SB(0, 0), b2, voffB);
            PG8_BAR; PG8_WAIT_L(0); PG8_MMA(0, 1, At, B1); PG8_BAR;
            PG8_LDA(At, 0, 1); PG8_STAGE(PG8_SA(0, 0), a2, voffA);
            PG8_BAR; PG8_WAIT_L(0); PG8_MMA(1, 0, At, B0); PG8_BAR; PG8_SCHED;
            PG8_STAGE(PG8_SB(0, 1), b2 + hstep, voffB);
            PG8_WAIT_V(6); PG8_BAR; PG8_MMA(1, 1, At, B1); PG8_BAR;
            PG8_LDB(B0, 1, 0); PG8_SCHED; PG8_LDA(At, 1, 0); PG8_STAGE(PG8_SA(0, 1), a2 + hstep, voffA);
            PG8_WAIT_L(8); PG8_BAR; PG8_WAIT_L(0); PG8_MMA(0, 0, At, B0); PG8_BAR; PG8_SCHED;
            PG8_LDB(B1, 1, 1); PG8_STAGE(PG8_SB(1, 0), b3, voffB);
            PG8_BAR; PG8_WAIT_L(0); PG8_MMA(0, 1, At, B1); PG8_BAR;
            PG8_LDA(At, 1, 1); PG8_STAGE(PG8_SA(1, 0), a3, voffA);
            PG8_BAR; PG8_WAIT_L(0); PG8_MMA(1, 0, At, B0); PG8_BAR; PG8_SCHED;
            PG8_STAGE(PG8_SB(1, 1), b3 + hstep, voffB);
            PG8_WAIT_V(6); PG8_BAR; PG8_MMA(1, 1, At, B1); PG8_BAR;
            }
        }
        if constexpr (ALIGN_EPI) { if (wr == 0) PG8_BAR; }
        if constexpr (!Epi::AFTER_DRAIN) { E(acc, cur, wr, wc, fr, fq); S.done(cur); }
        if (!has_next) break;
#pragma unroll
        for (int a = 0; a < 2; ++a)
#pragma unroll
            for (int b = 0; b < 2; ++b)
#pragma unroll
                for (int m = 0; m < 4; ++m)
#pragma unroll
                    for (int n = 0; n < 2; ++n) acc[a][b][m][n] = (f32x4){0.f, 0.f, 0.f, 0.f};
        cur = nxt; cA = nA; cB = nB; ++ui;
        if constexpr (ALIGN_EPI) { if (wr == 1) PG8_BAR; }
    }
    PG8_WAIT_V(0);
    if constexpr (!ALIGN_EPI) { if (wr == 0) PG8_BAR; }
    PG8_BAR;
    if constexpr (Epi::AFTER_DRAIN) { E.fused(acc, cur, wr, wc, fr, fq, lds, wid, lane); S.done(cur); }
#undef PG8_SA
#undef PG8_SB
#undef PG8_STAGE
#undef PG8_LDA
#undef PG8_LDB
#undef PG8_MMA
#undef PG8_WAIT_V
#undef PG8_WAIT_L
#undef PG8_BAR
#undef PG8_SCHED
}
}

constexpr int BATCH = 8, SEQ = 4096, DM = 1024, DEPTH = 4, NPAD = 112, LSEQ = 4224, MROWS = BATCH * LSEQ;
constexpr int NIN_LOG = 3744, NIN = 3840, DFF = 4096, DMIX = 1536;
constexpr float LN_EPS = 1e-5f, DN_ALPHA = 1.681792830507429f;
constexpr int NWAVES = 8, NTHREADS = 512;
constexpr int LDS_BYTES = 147456;
constexpr int NPHASES = 1 + 8 * DEPTH;

typedef unsigned short bf16;
typedef float f32x4 __attribute__((ext_vector_type(4)));
typedef float f32x2 __attribute__((ext_vector_type(2)));
typedef float f32x16 __attribute__((ext_vector_type(16)));
typedef short bf16x8 __attribute__((ext_vector_type(8)));
typedef unsigned u32x2 __attribute__((ext_vector_type(2)));
typedef unsigned u32x4 __attribute__((ext_vector_type(4)));
typedef __bf16 bf16x2_t __attribute__((ext_vector_type(2)));
#define LAS __attribute__((address_space(3)))

constexpr size_t MiB = 1u << 20;
constexpr size_t WS_H = 0, WS_HB = 132 * MiB, WS_W = 198 * MiB, WS_MISC = 226 * MiB, WS_B = 230 * MiB, WS_PART = 494 * MiB, WS_END = 510 * MiB;
constexpr size_t W_IN = 0, W_UQ = W_IN + (size_t)NIN * 1024 * 2, W_UKV = W_UQ + (size_t)768 * 384 * 2, W_OUT = W_UKV + (size_t)1024 * 256 * 2,
                 W_FF1 = W_OUT + (size_t)1024 * 1536 * 2, W_FF2 = W_FF1 + (size_t)4096 * 1024 * 2, W_TOTAL = W_FF2 + (size_t)1024 * 4096 * 2;
static_assert(W_TOTAL <= 28 * MiB, "weights region");
constexpr size_t MISC_CTL = 0, CTL_BYTES = 65536, MISC_TAB64 = 65536, MISC_TAB32 = MISC_TAB64 + (size_t)LSEQ * 32 * 8, MISC_SSQ = MISC_TAB32 + (size_t)LSEQ * 16 * 8,
                 MISC_END = MISC_SSQ + (size_t)12 * MROWS * 4;
static_assert(MISC_END <= 4 * MiB, "misc region");
constexpr size_t B_MIX = 0, B_KSB = 99 * MiB, B_VTSB = 132 * MiB, B_RQ = 165 * MiB, B_RK = B_RQ + 33 * MiB / 2, B_RVT = 198 * MiB, B_KN = 231 * MiB, B_U = 0;
constexpr size_t O_VTMLA = 0, O_CQ = 33 * MiB, O_CKV = O_CQ + (size_t)MROWS * 384 * 2, O_QR = O_CKV + (size_t)MROWS * 256 * 2, O_KR = O_QR + (size_t)MROWS * 256 * 2, O_END = O_KR + (size_t)MROWS * 32 * 2;
constexpr size_t O_DT = 93 * MiB, O_RKT = 109 * MiB;
static_assert(O_END <= O_DT && O_RKT + (size_t)MROWS * 256 * 2 <= 128 * MiB, "d_out scratch");

__device__ __forceinline__ unsigned f2bf(float f) { unsigned u = __builtin_bit_cast(unsigned, f); return (u + 0x7fffu + ((u >> 16) & 1u)) >> 16; }
__device__ __forceinline__ unsigned cvtpk(float lo, float hi) { f32x2 v = {lo, hi}; bf16x2_t b = __builtin_convertvector(v, bf16x2_t); return __builtin_bit_cast(unsigned, b); }
__device__ __forceinline__ float bf2f(unsigned short b) { return __builtin_bit_cast(float, (unsigned)b << 16); }
__device__ __forceinline__ float ex2(float x) { return __builtin_amdgcn_exp2f(x); }
__device__ __forceinline__ float wave_sum(float v) {
#pragma unroll
    for (int o = 1; o < 64; o <<= 1) v += __shfl_xor(v, o);
    return v;
}
__device__ __forceinline__ float ret_lg(int h) {
    return h == 0 ? -0.04580368961312479f : h == 1 ? -0.02272007650008353f : h == 2 ? -0.011315313227834146f : -0.005646563141142063f;
}

struct Ptrs {
    const float* in[16]; float* out; unsigned char* ws;
    float* H; bf16* HB; bf16* Win; bf16* Wuq; bf16* Wukv; bf16* Wout; bf16* W1; bf16* W2;
    unsigned* ctl; f32x2* tab64; f32x2* tab32; float* ssq;
    bf16 *MIX, *KSB, *VTSB, *RQ, *RK, *RVT, *KN, *U, *VTMLA, *CQ, *CKV, *QR, *KR, *RKT; float* DT;
};

#define GAS __attribute__((address_space(1)))
__device__ __forceinline__ void fill_ptrs(Ptrs& P, unsigned char* wsl_, float* outl_) {
    unsigned char* wsl = (unsigned char*)(GAS unsigned char*)wsl_; float* outl = (float*)(GAS float*)outl_;
    P.out = outl; P.ws = wsl;
    P.H = (float*)(wsl + WS_H); P.HB = (bf16*)(wsl + WS_HB);
    unsigned char* wb = wsl + WS_W;
    P.Win = (bf16*)(wb + W_IN); P.Wuq = (bf16*)(wb + W_UQ); P.Wukv = (bf16*)(wb + W_UKV); P.Wout = (bf16*)(wb + W_OUT); P.W1 = (bf16*)(wb + W_FF1); P.W2 = (bf16*)(wb + W_FF2);
    unsigned char* mb = wsl + WS_MISC;
    P.ctl = (unsigned*)(mb + MISC_CTL); P.tab64 = (f32x2*)(mb + MISC_TAB64); P.tab32 = (f32x2*)(mb + MISC_TAB32); P.ssq = (float*)(mb + MISC_SSQ);
    unsigned char* bb = wsl + WS_B;
    P.MIX = (bf16*)(bb + B_MIX); P.KSB = (bf16*)(bb + B_KSB); P.VTSB = (bf16*)(bb + B_VTSB); P.RQ = (bf16*)(bb + B_RQ); P.RK = (bf16*)(bb + B_RK); P.RVT = (bf16*)(bb + B_RVT);
    P.KN = (bf16*)(bb + B_KN); P.U = (bf16*)(bb + B_U);
    unsigned char* ob = (unsigned char*)outl;
    P.VTMLA = (bf16*)(ob + O_VTMLA); P.CQ = (bf16*)(ob + O_CQ); P.CKV = (bf16*)(ob + O_CKV); P.QR = (bf16*)(ob + O_QR); P.KR = (bf16*)(ob + O_KR); P.RKT = (bf16*)(ob + O_RKT); P.DT = (float*)(ob + O_DT);
}
#define EPI_PTRS Ptrs P; { size_t z_ = 0; asm volatile("" : "+s"(z_)); fill_ptrs(P, ws_ + z_, out_ + z_); } \
                 float* ssq_q = P.ssq; float* ssq_kv = P.ssq + (size_t)8 * MROWS; (void)ssq_q; (void)ssq_kv; (void)layer_;
using pg8::Unit;
#define EPI_ROWS_BEGIN  _Pragma("unroll") for (int ai = 0; ai < 2; ++ai) _Pragma("unroll") for (int m = 0; m < 4; ++m) { const int row = u.pm * 256 + ai * 128 + wr * 64 + m * 16 + fr; const int cl = wc * 32 + fq * 4; (void)cl;
#define EPI_ROWS_END    asm volatile("" ::: "memory"); }
#define EPI_COLS_BEGIN  _Pragma("unroll") for (int bj = 0; bj < 2; ++bj) _Pragma("unroll") for (int n = 0; n < 2; ++n) { const int co = bj * 128 + n * 16; const int c = co + cl; (void)c; const f32x4 v = acc[ai][bj][m][n];
#define EPI_COLS_END    }

__device__ __forceinline__ void st_bf4(bf16* p, f32x4 v) { u32x2 w; w.x = cvtpk(v[0], v[1]); w.y = cvtpk(v[2], v[3]); *(u32x2*)p = w; }

struct EpiIn {
    static constexpr bool PERM = false, AFTER_DRAIN = false;
    unsigned char* ws_; float* out_; int layer_;
    __device__ __forceinline__ void plain(const f32x4 (&acc)[2][2][4][2], const Unit& u, int wr, int wc, int fr, int fq, bf16* dst, int ld, int col0) const {
        EPI_ROWS_BEGIN
            bf16* rp = dst + (unsigned)(row * ld + col0 + cl);
            EPI_COLS_BEGIN st_bf4(rp + co, v); EPI_COLS_END
        EPI_ROWS_END
    }
    template <int HD> __device__ __forceinline__ void transposed(const f32x4 (&acc)[2][2][4][2], const Unit& u, int wr, int wc, int fr, int fq, bf16* dst, int cc0) const {
        constexpr int NH = 512 / HD;
        EPI_ROWS_BEGIN
            const int b = row / LSEQ, t = row - b * LSEQ;
            EPI_COLS_BEGIN
                const int cc = cc0 + c, head = cc / HD, d = cc % HD;
                bf16* q = dst + ((size_t)(b * NH + head) * HD + d) * LSEQ + t;
                q[0] = (bf16)f2bf(v[0]); q[LSEQ] = (bf16)f2bf(v[1]); q[2 * LSEQ] = (bf16)f2bf(v[2]); q[3 * LSEQ] = (bf16)f2bf(v[3]);
            EPI_COLS_END
        EPI_ROWS_END
    }
    __device__ __forceinline__ void withssq(const f32x4 (&acc)[2][2][4][2], const Unit& u, int wr, int wc, int fr, int fq, bf16* dst, int ld, int col0, float* ssq, int nbj, int nslot, int slot0) const {
        EPI_ROWS_BEGIN
            float s = 0.f; bf16* rp = dst + (unsigned)(row * ld + col0 + cl);
#pragma unroll
            for (int bj = 0; bj < 2; ++bj) if (bj < nbj) {
#pragma unroll
                for (int n = 0; n < 2; ++n) { const f32x4 v = acc[ai][bj][m][n];
                    st_bf4(rp + bj * 128 + n * 16, v); s += (v[0] * v[0] + v[1] * v[1]) + (v[2] * v[2] + v[3] * v[3]); } }
            s += __shfl_xor(s, 16); s += __shfl_xor(s, 32);
            if (fq == 0) ssq[(unsigned)(row * nslot + slot0 + wc)] = s;
        EPI_ROWS_END
    }
    template <bool ISK> __device__ __forceinline__ void rope64(const Ptrs& P, const f32x4 (&acc)[2][2][4][2], const Unit& u, int wr, int wc, int fr, int fq, bf16* dst) const {
        EPI_ROWS_BEGIN
            const int b = row / LSEQ, t = row - b * LSEQ; const int d0 = 16 * (wc & 1) + 4 * fq;
            const f32x4* tp = (const f32x4*)(P.tab64 + (size_t)t * 32 + d0); const f32x4 cs0 = tp[0], cs1 = tp[1];
#pragma unroll
            for (int bj = 0; bj < 2; ++bj) { const int hd = 2 * bj + (wc >> 1); const f32x4 x1 = acc[ai][bj][m][0], x2 = acc[ai][bj][m][1];
                float f;
                if (ISK) f = (t >= NPAD) ? ex2(-(float)(t & 63) * ret_lg(hd)) : 0.f; else f = ex2((float)(t & 31) * ret_lg(hd));
                f32x4 o1, o2;
                o1[0] = (x1[0] * cs0[0] - x2[0] * cs0[1]) * f; o2[0] = (x1[0] * cs0[1] + x2[0] * cs0[0]) * f;
                o1[1] = (x1[1] * cs0[2] - x2[1] * cs0[3]) * f; o2[1] = (x1[1] * cs0[3] + x2[1] * cs0[2]) * f;
                o1[2] = (x1[2] * cs1[0] - x2[2] * cs1[1]) * f; o2[2] = (x1[2] * cs1[1] + x2[2] * cs1[0]) * f;
                o1[3] = (x1[3] * cs1[2] - x2[3] * cs1[3]) * f; o2[3] = (x1[3] * cs1[3] + x2[3] * cs1[2]) * f;
                bf16* q = dst + (size_t)row * 256 + 64 * hd + d0; st_bf4(q, o1); st_bf4(q + 32, o2);
                if (ISK) { bf16* qt = P.RKT + ((size_t)(b * 4 + hd) * 64 + d0) * LSEQ + t;
#pragma unroll
                    for (int j = 0; j < 4; ++j) { qt[(size_t)j * LSEQ] = (bf16)f2bf(o1[j]); qt[(size_t)(32 + j) * LSEQ] = (bf16)f2bf(o2[j]); } } }
        EPI_ROWS_END
    }
    __device__ __forceinline__ void operator()(const f32x4 (&acc)[2][2][4][2], const Unit& u, int wr, int wc, int fr, int fq) const {
        const int pn = u.pn; EPI_PTRS
        if (pn < 2) plain(acc, u, wr, wc, fr, fq, P.MIX, DMIX, pn * 256);
        else if (pn < 4) plain(acc, u, wr, wc, fr, fq, P.KSB, 512, (pn - 2) * 256);
        else if (pn < 6) transposed<64>(acc, u, wr, wc, fr, fq, P.VTSB, (pn - 4) * 256);
        else if (pn == 6) rope64<false>(P, acc, u, wr, wc, fr, fq, P.RQ);
        else if (pn == 7) rope64<true>(P, acc, u, wr, wc, fr, fq, P.RK);
        else if (pn < 10) transposed<128>(acc, u, wr, wc, fr, fq, P.RVT, (pn - 8) * 256);
        else if (pn < 12) plain(acc, u, wr, wc, fr, fq, P.MIX, DMIX, 1024 + (pn - 10) * 256);
        else if (pn == 12) withssq(acc, u, wr, wc, fr, fq, P.CKV, 256, 0, ssq_kv, 2, 4, 0);
        else if (pn == 13) withssq(acc, u, wr, wc, fr, fq, P.CQ, 384, 0, ssq_q, 2, 8, 0);
        else {
            withssq(acc, u, wr, wc, fr, fq, P.CQ, 384, 256, ssq_q, 1, 8, 4);
            if (wc == 0) {
                EPI_ROWS_BEGIN
                    const int b = row / LSEQ, t = row - b * LSEQ;
                    const f32x4* tp = (const f32x4*)(P.tab32 + (size_t)t * 16 + 4 * fq); const f32x4 cs0 = tp[0], cs1 = tp[1];
                    const f32x4 x1 = acc[ai][1][m][0], x2 = acc[ai][1][m][1]; f32x4 o1, o2;
                    o1[0] = x1[0] * cs0[0] - x2[0] * cs0[1]; o2[0] = x1[0] * cs0[1] + x2[0] * cs0[0];
                    o1[1] = x1[1] * cs0[2] - x2[1] * cs0[3]; o2[1] = x1[1] * cs0[3] + x2[1] * cs0[2];
                    o1[2] = x1[2] * cs1[0] - x2[2] * cs1[1]; o2[2] = x1[2] * cs1[1] + x2[2] * cs1[0];
                    o1[3] = x1[3] * cs1[2] - x2[3] * cs1[3]; o2[3] = x1[3] * cs1[3] + x2[3] * cs1[2];
                    bf16* q = P.KR + (size_t)row * 32 + 4 * fq; st_bf4(q, o1); st_bf4(q + 16, o2);
                EPI_ROWS_END
            }
        }
    }
};

struct EpiUq {
    static constexpr bool PERM = false, AFTER_DRAIN = false;
    unsigned char* ws_; float* out_; int layer_;
    __device__ __forceinline__ void operator()(const f32x4 (&acc)[2][2][4][2], const Unit& u, int wr, int wc, int fr, int fq) const {
        const int pn = u.pn; EPI_PTRS
        if (pn < 2) {
            EPI_ROWS_BEGIN
                const f32x4 sa_ = *(const f32x4*)(ssq_q + (size_t)row * 8), sb_ = *(const f32x4*)(ssq_q + (size_t)row * 8 + 4); const float ri = 1.0f / sqrtf((((sa_[0] + sa_[1]) + (sa_[2] + sa_[3])) + ((sb_[0] + sb_[1]) + (sb_[2] + sb_[3]))) * (1.0f / 384.0f) + LN_EPS);
                bf16* rp = P.MIX + (unsigned)(row * DMIX + 512 + pn * 256 + cl);
                EPI_COLS_BEGIN st_bf4(rp + co, v * ri); EPI_COLS_END
            EPI_ROWS_END
        } else {
            EPI_ROWS_BEGIN
                const f32x4 sa_ = *(const f32x4*)(ssq_q + (size_t)row * 8), sb_ = *(const f32x4*)(ssq_q + (size_t)row * 8 + 4); const float ri = 1.0f / sqrtf((((sa_[0] + sa_[1]) + (sa_[2] + sa_[3])) + ((sb_[0] + sb_[1]) + (sb_[2] + sb_[3]))) * (1.0f / 384.0f) + LN_EPS);
                const int b = row / LSEQ, t = row - b * LSEQ;
                const f32x4* tp = (const f32x4*)(P.tab32 + (size_t)t * 16 + 4 * fq); const f32x4 cs0 = tp[0], cs1 = tp[1];
#pragma unroll
                for (int bj = 0; bj < 2; ++bj) { const int head = 4 * bj + wc; const f32x4 x1 = acc[ai][bj][m][0] * ri, x2 = acc[ai][bj][m][1] * ri; f32x4 o1, o2;
                    o1[0] = x1[0] * cs0[0] - x2[0] * cs0[1]; o2[0] = x1[0] * cs0[1] + x2[0] * cs0[0];
                    o1[1] = x1[1] * cs0[2] - x2[1] * cs0[3]; o2[1] = x1[1] * cs0[3] + x2[1] * cs0[2];
                    o1[2] = x1[2] * cs1[0] - x2[2] * cs1[1]; o2[2] = x1[2] * cs1[1] + x2[2] * cs1[0];
                    o1[3] = x1[3] * cs1[2] - x2[3] * cs1[3]; o2[3] = x1[3] * cs1[3] + x2[3] * cs1[2];
                    bf16* q = P.QR + (size_t)row * 256 + 32 * head + 4 * fq; st_bf4(q, o1); st_bf4(q + 16, o2); }
            EPI_ROWS_END
        }
    }
};

struct EpiUkv {
    static constexpr bool PERM = false, AFTER_DRAIN = false;
    unsigned char* ws_; float* out_; int layer_;
    __device__ __forceinline__ void operator()(const f32x4 (&acc)[2][2][4][2], const Unit& u, int wr, int wc, int fr, int fq) const {
        const int pn = u.pn; EPI_PTRS
        if (pn < 2) {
            EPI_ROWS_BEGIN
                const f32x4 sa_ = *(const f32x4*)(ssq_kv + (size_t)row * 4); const float ri = 1.0f / sqrtf(((sa_[0] + sa_[1]) + (sa_[2] + sa_[3])) * (1.0f / 256.0f) + LN_EPS);
                bf16* rp = P.KN + (unsigned)(row * 512 + pn * 256 + cl);
                EPI_COLS_BEGIN st_bf4(rp + co, v * ri); EPI_COLS_END
            EPI_ROWS_END
        } else {
            EPI_ROWS_BEGIN
                const f32x4 sa_ = *(const f32x4*)(ssq_kv + (size_t)row * 4); const float ri = 1.0f / sqrtf(((sa_[0] + sa_[1]) + (sa_[2] + sa_[3])) * (1.0f / 256.0f) + LN_EPS);
                const int b = row / LSEQ, t = row - b * LSEQ;
                EPI_COLS_BEGIN
                    const int cc = (pn - 2) * 256 + c, head = cc >> 6, d = cc & 63;
                    bf16* q = P.VTMLA + ((size_t)(b * 8 + head) * 64 + d) * LSEQ + t;
                    q[0] = (bf16)f2bf(v[0] * ri); q[LSEQ] = (bf16)f2bf(v[1] * ri); q[2 * LSEQ] = (bf16)f2bf(v[2] * ri); q[3 * LSEQ] = (bf16)f2bf(v[3] * ri);
                EPI_COLS_END
            EPI_ROWS_END
        }
    }
};

struct EpiRes {
    static constexpr bool PERM = true, AFTER_DRAIN = false;
    float* H;
    __device__ __forceinline__ void operator()(const f32x4 (&acc)[2][2][4][2], const Unit& u, int wr, int wc, int fr, int fq) const {
        EPI_ROWS_BEGIN
            float* rp = H + (unsigned)(row * DM + u.pn * 256 + wc * 32 + fq * 8);
#pragma unroll
            for (int bj = 0; bj < 2; ++bj) { f32x4* q = (f32x4*)(rp + bj * 128); const f32x4 h0 = q[0], h1 = q[1];
                q[0] = h0 * DN_ALPHA + acc[ai][bj][m][0]; q[1] = h1 * DN_ALPHA + acc[ai][bj][m][1]; }
        EPI_ROWS_END
    }
};

struct EpiResT {
    static constexpr bool PERM = true, AFTER_DRAIN = false;
    bf16* T;
    __device__ __forceinline__ void operator()(const f32x4 (&acc)[2][2][4][2], const Unit& u, int wr, int wc, int fr, int fq) const {
        EPI_ROWS_BEGIN
            bf16* rp = T + (unsigned)(row * DM + u.pn * 256 + wc * 32 + fq * 8);
#pragma unroll
            for (int bj = 0; bj < 2; ++bj) { const f32x4 a0 = acc[ai][bj][m][0], a1 = acc[ai][bj][m][1];
                *(u32x4*)(rp + bj * 128) = (u32x4){cvtpk(a0[0], a0[1]), cvtpk(a0[2], a0[3]), cvtpk(a1[0], a1[1]), cvtpk(a1[2], a1[3])}; }
        EPI_ROWS_END
    }
};

struct EpiFf1 {
    static constexpr bool PERM = true, AFTER_DRAIN = false;
    bf16* U;
    __device__ __forceinline__ void operator()(const f32x4 (&acc)[2][2][4][2], const Unit& u, int wr, int wc, int fr, int fq) const {
        EPI_ROWS_BEGIN
            bf16* rp = U + (unsigned)(row * DFF + u.pn * 256 + wc * 32 + fq * 8);
#pragma unroll
            for (int bj = 0; bj < 2; ++bj) { f32x4 a0 = acc[ai][bj][m][0], a1 = acc[ai][bj][m][1];
#pragma unroll
                for (int j = 0; j < 4; ++j) { a0[j] = fmaxf(a0[j], 0.f); a1[j] = fmaxf(a1[j], 0.f); }
                a0 = a0 * a0; a1 = a1 * a1;
                *(u32x4*)(rp + bj * 128) = (u32x4){cvtpk(a0[0], a0[1]), cvtpk(a0[2], a0[3]), cvtpk(a1[0], a1[1]), cvtpk(a1[2], a1[3])}; }
        EPI_ROWS_END
    }
};

constexpr int TAIL_PM0 = 128, TAIL_ROW0 = TAIL_PM0 * 256, NSPLIT = 4;
struct EpiPart {
    static constexpr bool PERM = true, AFTER_DRAIN = false;
    float* PART; int ktper;
    __device__ __forceinline__ void operator()(const f32x4 (&acc)[2][2][4][2], const Unit& u, int wr, int wc, int fr, int fq) const {
        float* slab = PART + (size_t)(u.kt0 / ktper) * (1024 * 1024);
        EPI_ROWS_BEGIN
            float* rp = slab + (unsigned)((row - TAIL_ROW0) * DM + u.pn * 256 + wc * 32 + fq * 8);
#pragma unroll
            for (int bj = 0; bj < 2; ++bj) { f32x4* q = (f32x4*)(rp + bj * 128); q[0] = acc[ai][bj][m][0]; q[1] = acc[ai][bj][m][1]; }
        EPI_ROWS_END
    }
};
struct TailOrder {
    int G, c, ktper;
    __device__ bool next(int i, Unit& u) const { const int Lx = i * G + c; if (Lx >= 16 * NSPLIT) return false; const int tile = Lx / NSPLIT, ks = Lx % NSPLIT;
        u.pm = TAIL_PM0 + (tile >> 2); u.pn = tile & 3; u.kt0 = ks * ktper; return true; }
    __device__ __forceinline__ void a_ready(const Unit&) const {}
    __device__ __forceinline__ void done(const Unit&) const {}
};

namespace att {
constexpr int KBUF = 64 * 208, VBUF = 128 * 144, OFF_K = 0, OFF_V = 2 * KBUF, OFF_WS = OFF_V + 2 * VBUF, OFF_UNIT = OFF_WS + 8 * 256, OFF_ST = OFF_UNIT + 256, STROW = 144;
__device__ __forceinline__ int crow(int r, int hi) { return (r & 3) + 8 * (r >> 2) + 4 * hi; }
#define MFMA32(a, b, c) __builtin_amdgcn_mfma_f32_32x32x16_bf16((a), (b), (c), 0, 0, 0)


__device__ __forceinline__ void pack4(const f32x16& p0, const f32x16& p1, u32x4 (&pf)[4]) {
    pf[0] = (u32x4){cvtpk(p0[0], p0[1]), cvtpk(p0[2], p0[3]), cvtpk(p0[4], p0[5]), cvtpk(p0[6], p0[7])};
    pf[1] = (u32x4){cvtpk(p0[8], p0[9]), cvtpk(p0[10], p0[11]), cvtpk(p0[12], p0[13]), cvtpk(p0[14], p0[15])};
    pf[2] = (u32x4){cvtpk(p1[0], p1[1]), cvtpk(p1[2], p1[3]), cvtpk(p1[4], p1[5]), cvtpk(p1[6], p1[7])};
    pf[3] = (u32x4){cvtpk(p1[8], p1[9]), cvtpk(p1[10], p1[11]), cvtpk(p1[12], p1[13]), cvtpk(p1[14], p1[15])};
}
template <bool MASK>
__device__ __forceinline__ void sb_sub(const f32x16& p, int keybase, int tq, int hi, float& carry, u32x4& f0, u32x4& f1) {
    float kp[16];
#pragma unroll
    for (int r = 0; r < 16; ++r) {
        const float e = ex2(p[r]); float kk = __builtin_amdgcn_rcpf(1.0f + e);
        if (MASK) { const int key = keybase + crow(r, hi); const bool ok = (key < tq) && (key >= NPAD); kk = ok ? kk : 1.0f; }
        kp[r] = kk;
    }
    float G[4], Gp[4], GG[4];
#pragma unroll
    for (int q = 0; q < 4; ++q) { G[q] = (kp[4 * q] * kp[4 * q + 1]) * (kp[4 * q + 2] * kp[4 * q + 3]);
        const auto rr = __builtin_amdgcn_permlane32_swap(__float_as_uint(G[q]), __float_as_uint(G[q]), false, false);
        Gp[q] = __uint_as_float(rr[1]); GG[q] = __uint_as_float(rr[0]) * __uint_as_float(rr[1]); }
    float T[4]; T[3] = 1.0f; T[2] = GG[3]; T[1] = GG[3] * GG[2]; T[0] = T[1] * GG[1];
    float w[16];
#pragma unroll
    for (int q = 0; q < 4; ++q) {
        const float e3 = carry * T[q] * (hi == 0 ? Gp[q] : 1.0f);
        const float e2 = e3 * kp[4 * q + 3], e1 = e2 * kp[4 * q + 2], e0 = e1 * kp[4 * q + 1], em = e0 * kp[4 * q];
        w[4 * q + 3] = e3 - e2; w[4 * q + 2] = e2 - e1; w[4 * q + 1] = e1 - e0; w[4 * q] = e0 - em;
    }
    carry *= T[0] * GG[0];
    f0 = (u32x4){cvtpk(w[0], w[1]), cvtpk(w[2], w[3]), cvtpk(w[4], w[5]), cvtpk(w[6], w[7])};
    f1 = (u32x4){cvtpk(w[8], w[9]), cvtpk(w[10], w[11]), cvtpk(w[12], w[13]), cvtpk(w[14], w[15])};
}
template <int KIND>
__device__ __forceinline__ void unit(const Ptrs& P, int bh, int u, LAS unsigned char* lds, bool do_store) {
    constexpr int DQK = (KIND == 1) ? 96 : 64, DV = (KIND == 2) ? 128 : 64, NH = (KIND == 2) ? 4 : 8, KROW = DQK * 2 + 16, VROW = 144, NQF = DQK / 16, NDB = DV / 32;
    int tid_l = threadIdx.x; asm volatile("" : "+v"(tid_l));
    const int tid = tid_l, lane = tid & 63, r32 = lane & 31, hi = lane >> 5, wid = __builtin_amdgcn_readfirstlane(tid >> 6);
    const int b = bh / NH, h = bh % NH;
    const int q0 = (u == 0) ? 0 : 128 + 256 * (u - 1), nrows = (u == 0) ? 128 : 256, ktmax = (u == 0) ? 1 : 4 * u + 1;
    const size_t rowb = (size_t)b * LSEQ;
    const bool active = (32 * wid < nrows);
    const int q0w = q0 + 32 * wid, tq = q0w + r32, ktw = (q0w + 31) >> 6;
    const bf16* Qb; int ldq; const bf16* Kb; int ldk; const bf16* VT;
    if (KIND == 0) { Qb = P.MIX + h * 64; ldq = DMIX; Kb = P.KSB + h * 64; ldk = 512; VT = P.VTSB; }
    else if (KIND == 1) { Qb = P.MIX + 512 + h * 64; ldq = DMIX; Kb = P.KN + h * 64; ldk = 512; VT = P.VTMLA; }
    else { Qb = P.RQ + h * 64; ldq = 256; Kb = P.RK + h * 64; ldk = 256; VT = P.RVT; }
    VT += (size_t)bh * DV * LSEQ;
    bf16x8 qf[NQF];
#pragma unroll
    for (int d0 = 0; d0 < NQF; ++d0) qf[d0] = (bf16x8){0, 0, 0, 0, 0, 0, 0, 0};
    if (active) {
#pragma unroll
        for (int d0 = 0; d0 < 4; ++d0) qf[d0] = *(const bf16x8*)(Qb + (rowb + tq) * ldq + 16 * d0 + 8 * hi);
        if (KIND == 1) {
#pragma unroll
            for (int d0 = 0; d0 < 2; ++d0) qf[(KIND == 1) ? 4 + d0 : 0] = *(const bf16x8*)(P.QR + (rowb + tq) * 256 + h * 32 + 16 * d0 + 8 * hi);
        }
    }
    f32x16 o[NDB];
#pragma unroll
    for (int d = 0; d < NDB; ++d) o[d] = (f32x16){0.f, 0.f, 0.f, 0.f, 0.f, 0.f, 0.f, 0.f, 0.f, 0.f, 0.f, 0.f, 0.f, 0.f, 0.f, 0.f};
    float carry = 1.0f, mrun = -1e30f, lrun = 0.f;
    LAS float* wsf = (LAS float*)(lds + OFF_WS) + wid * 64;
    u32x4 kreg, kreg2 = (u32x4){0u, 0u, 0u, 0u}, vreg[DV / 64];
    const int srow = tid >> 3, sch = tid & 7;
#define ATT_LOAD(kt_) do { const size_t key0_ = rowb + (size_t)64 * (kt_); \
        kreg = *(const u32x4*)(Kb + (key0_ + srow) * ldk + sch * 8); \
        if (KIND == 1 && tid < 256) kreg2 = *(const u32x4*)(P.KR + (key0_ + (tid >> 2)) * 32 + (tid & 3) * 8); \
        _Pragma("unroll") for (int i_ = 0; i_ < DV / 64; ++i_) vreg[i_] = *(const u32x4*)(VT + (size_t)(srow + 64 * i_) * LSEQ + 64 * (kt_) + sch * 8); } while (0)
#define ATT_WRITE(buf_) do { LAS unsigned char* kb_ = lds + OFF_K + (buf_) * KBUF; LAS unsigned char* vb_ = lds + OFF_V + (buf_) * VBUF; \
        *(LAS u32x4*)(kb_ + srow * KROW + sch * 16) = kreg; \
        if (KIND == 1 && tid < 256) *(LAS u32x4*)(kb_ + (tid >> 2) * KROW + 128 + (tid & 3) * 16) = kreg2; \
        _Pragma("unroll") for (int i_ = 0; i_ < DV / 64; ++i_) { LAS unsigned char* q_ = vb_ + (srow + 64 * i_) * VROW + (sch >> 1) * 32 + (sch & 1) * 8; \
            *(LAS u32x2*)q_ = (u32x2){vreg[i_].x, vreg[i_].y}; *(LAS u32x2*)(q_ + 16) = (u32x2){vreg[i_].z, vreg[i_].w}; } } while (0)

    int ktmin = 1;
    if (KIND == 2 && u >= 1) {
        ktmin = q0 >> 6;
        const float g256 = ex2(256.0f * ret_lg(h));
        const int e_ = tid >> 2, dseg = (tid & 3) * 16;
        const float* dp = P.DT + ((size_t)bh * 16 * 128 + e_) * 64 + dseg;
        f32x4 sacc[4];
#pragma unroll
        for (int c_ = 0; c_ < 4; ++c_) sacc[c_] = (f32x4){0.f, 0.f, 0.f, 0.f};
        int blk = 0;
        for (; blk + 4 <= u; blk += 4) {
            f32x4 ld_[4][4];
#pragma unroll
            for (int i_ = 0; i_ < 4; ++i_)
#pragma unroll
                for (int c_ = 0; c_ < 4; ++c_) ld_[i_][c_] = *(const f32x4*)(dp + (size_t)(blk + i_) * 128 * 64 + 4 * c_);
#pragma unroll
            for (int i_ = 0; i_ < 4; ++i_)
#pragma unroll
                for (int c_ = 0; c_ < 4; ++c_) sacc[c_] = sacc[c_] * g256 + ld_[i_][c_];
        }
        for (; blk < u; ++blk) {
#pragma unroll
            for (int c_ = 0; c_ < 4; ++c_) sacc[c_] = sacc[c_] * g256 + *(const f32x4*)(dp + (size_t)blk * 128 * 64 + 4 * c_);
        }
        LAS unsigned char* stp = lds + OFF_ST + e_ * STROW + dseg * 2;
        *(LAS u32x4*)stp = (u32x4){cvtpk(sacc[0][0], sacc[0][1]), cvtpk(sacc[0][2], sacc[0][3]), cvtpk(sacc[1][0], sacc[1][1]), cvtpk(sacc[1][2], sacc[1][3])};
        *(LAS u32x4*)(stp + 16) = (u32x4){cvtpk(sacc[2][0], sacc[2][1]), cvtpk(sacc[2][2], sacc[2][3]), cvtpk(sacc[3][0], sacc[3][1]), cvtpk(sacc[3][2], sacc[3][3])};
        __syncthreads();
        if (active) {
#pragma unroll
            for (int s_ = 0; s_ < 4; ++s_)
#pragma unroll
                for (int d = 0; d < NDB; ++d) {
                    const bf16x8 sf = *(const LAS bf16x8*)(lds + OFF_ST + (32 * d + r32) * STROW + (16 * s_ + 8 * hi) * 2);
                    o[d] = MFMA32(qf[s_], sf, o[d]);
                }
            const float gw_ = ex2((float)(32 * wid) * ret_lg(h));
#pragma unroll
            for (int d = 0; d < NDB; ++d)
#pragma unroll
                for (int r = 0; r < 16; ++r) o[d][r] *= gw_;
        }
    }
    int buf = 0;
    ATT_LOAD(ktmax); ATT_WRITE(0);
    __syncthreads();
    for (int kt = ktmax; kt >= ktmin; --kt) {
        if (kt > ktmin) ATT_LOAD(kt - 1);
        if (active && kt <= ktw) {
            const LAS unsigned char* Kt = lds + OFF_K + buf * KBUF; const LAS unsigned char* Vt = lds + OFF_V + buf * VBUF;
            f32x16 p0 = (f32x16){0.f, 0.f, 0.f, 0.f, 0.f, 0.f, 0.f, 0.f, 0.f, 0.f, 0.f, 0.f, 0.f, 0.f, 0.f, 0.f}, p1 = p0;
            {
                bf16x8 kfa[NQF], kfb[NQF];
#pragma unroll
                for (int d0 = 0; d0 < NQF; ++d0) { kfa[d0] = *(const LAS bf16x8*)(Kt + r32 * KROW + (16 * d0 + 8 * hi) * 2); kfb[d0] = *(const LAS bf16x8*)(Kt + (32 + r32) * KROW + (16 * d0 + 8 * hi) * 2); }
#pragma unroll
                for (int d0 = 0; d0 < NQF; ++d0) { p0 = MFMA32(kfa[d0], qf[d0], p0); p1 = MFMA32(kfb[d0], qf[d0], p1); }
            }
            bf16x8 vfr[(NDB == 2) ? 8 : 1];
            if (NDB == 2) {
#pragma unroll
                for (int ks = 0; ks < 4; ++ks)
#pragma unroll
                    for (int d = 0; d < 2; ++d) vfr[(NDB == 2) ? 2 * ks + d : 0] = *(const LAS bf16x8*)(Vt + (32 * d + r32) * VROW + (16 * ks + 8 * hi) * 2);
            }
            const int k0key = 64 * kt;
            const bool needmask = (k0key + 63 >= q0w) || (kt == 1);
            u32x4 pf[4];
            if (KIND == 0) {
                if (needmask) { sb_sub<true>(p1, k0key + 32, tq, hi, carry, pf[2], pf[3]); sb_sub<true>(p0, k0key, tq, hi, carry, pf[0], pf[1]); }
                else { sb_sub<false>(p1, k0key + 32, tq, hi, carry, pf[2], pf[3]); sb_sub<false>(p0, k0key, tq, hi, carry, pf[0], pf[1]); }
            } else if (KIND == 1) {
                if (needmask) {
#pragma unroll
                    for (int r = 0; r < 16; ++r) { const int key = k0key + crow(r, hi);
                        if (!((key <= tq) && (key >= NPAD))) p0[r] = -1e30f;
                        if (!((key + 32 <= tq) && (key + 32 >= NPAD))) p1[r] = -1e30f; }
                    asm volatile("" : "+v"(p0), "+v"(p1));
                }
                float mx = fmaxf(p0[0], p1[0]);
#pragma unroll
                for (int r = 1; r < 16; ++r) mx = fmaxf(mx, fmaxf(p0[r], p1[r]));
                { const auto rr = __builtin_amdgcn_permlane32_swap(__float_as_uint(mx), __float_as_uint(mx), false, false); mx = fmaxf(__uint_as_float(rr[0]), __uint_as_float(rr[1])); }
                const float mnew = fmaxf(mrun, mx);
                if (__any(mnew > mrun)) {
                    const float alpha = ex2(mrun - mnew); lrun *= alpha;
                    if (hi == 0) wsf[r32] = alpha;
                    asm volatile("s_waitcnt lgkmcnt(0)" ::: "memory");
#pragma unroll
                    for (int r = 0; r < 16; ++r) { const float a = wsf[crow(r, hi)];
#pragma unroll
                        for (int d = 0; d < NDB; ++d) o[d][r] *= a; }
                    asm volatile("s_waitcnt lgkmcnt(0)" ::: "memory");
                }
                mrun = mnew;
                float ls = 0.f;
#pragma unroll
                for (int r = 0; r < 16; ++r) { p0[r] = ex2(p0[r] - mrun); p1[r] = ex2(p1[r] - mrun); ls += p0[r] + p1[r]; }
                lrun += ls;
                pack4(p0, p1, pf);
            } else {
                const float cdec = ex2((float)(q0w - k0key) * ret_lg(h));
#pragma unroll
                for (int r = 0; r < 16; ++r) { p0[r] *= cdec; p1[r] *= cdec; }
                if (needmask) {
#pragma unroll
                    for (int r = 0; r < 16; ++r) { const int key = k0key + crow(r, hi); if (key > tq) p0[r] = 0.f; if (key + 32 > tq) p1[r] = 0.f; }
                    asm volatile("" : "+v"(p0), "+v"(p1));
                }
                pack4(p0, p1, pf);
            }
#pragma unroll
            for (int ks = 0; ks < 4; ++ks) {
                const bf16x8 pa = __builtin_bit_cast(bf16x8, pf[ks]);
#pragma unroll
                for (int d = 0; d < NDB; ++d) {
                    const bf16x8 vf = (NDB == 2) ? vfr[(NDB == 2) ? 2 * ks + d : 0] : *(const LAS bf16x8*)(Vt + (32 * d + r32) * VROW + (16 * ks + 8 * hi) * 2);
                    o[d] = MFMA32(pa, vf, o[d]);
                }
            }
        }
        if (kt > ktmin) ATT_WRITE(buf ^ 1);
        __syncthreads();
        buf ^= 1;
    }
#undef ATT_LOAD
#undef ATT_WRITE
    if (active && do_store) {
        if (KIND == 0) {
#pragma unroll
            for (int r = 0; r < 16; ++r) { bf16* q = P.MIX + (rowb + q0w + crow(r, hi)) * DMIX + h * 64 + r32;
#pragma unroll
                for (int d = 0; d < NDB; ++d) q[32 * d] = (bf16)f2bf(o[d][r]); }
        } else if (KIND == 1) {
            const float lt = lrun + __shfl_xor(lrun, 32);
            if (hi == 0) wsf[r32] = lt;
            asm volatile("s_waitcnt lgkmcnt(0)" ::: "memory");
#pragma unroll
            for (int r = 0; r < 16; ++r) { const float l_ = wsf[crow(r, hi)]; const float inv = l_ > 0.f ? 1.0f / l_ : 0.f;
                bf16* q = P.MIX + (rowb + q0w + crow(r, hi)) * DMIX + 512 + h * 64 + r32;
#pragma unroll
                for (int d = 0; d < NDB; ++d) q[32 * d] = (bf16)f2bf(o[d][r] * inv); }
            asm volatile("s_waitcnt lgkmcnt(0)" ::: "memory");
        } else {
#pragma unroll
            for (int r = 0; r < 16; ++r) {
                float s = 0.f;
#pragma unroll
                for (int d = 0; d < NDB; ++d) s += o[d][r];
#pragma unroll
                for (int x = 1; x < 32; x <<= 1) s += __shfl_xor(s, x);
                const float mean = s * (1.0f / 128.0f); float q2 = 0.f;
#pragma unroll
                for (int d = 0; d < NDB; ++d) { const float dd = o[d][r] - mean; q2 += dd * dd; }
#pragma unroll
                for (int x = 1; x < 32; x <<= 1) q2 += __shfl_xor(q2, x);
                const float rstd = 1.0f / sqrtf(q2 * (1.0f / 128.0f) + LN_EPS);
                bf16* q = P.MIX + (rowb + q0w + crow(r, hi)) * DMIX + 1024 + h * 128 + r32;
#pragma unroll
                for (int d = 0; d < NDB; ++d) { const float g = bf2f(q[32 * d]); const float sl = g / (1.0f + ex2(-g * 1.4426950408889634f));
                    q[32 * d] = (bf16)f2bf(sl * (o[d][r] - mean) * rstd); }
            }
        }
    }
}
__device__ __forceinline__ void ret_state_jobs(const Ptrs& P) {
    int tid_l = threadIdx.x; asm volatile("" : "+v"(tid_l));
    const int lane = tid_l & 63, r32 = lane & 31, hi = lane >> 5, wid = __builtin_amdgcn_readfirstlane(tid_l >> 6), eb = wid >> 1, db = wid & 1;
    for (int job = blockIdx.x; job < 32 * 16; job += gridDim.x) {
        const int bh = job >> 4, blk = job & 15, h = bh & 3;
        const int key0 = blk == 0 ? 0 : 128 + 256 * (blk - 1), ntile = blk == 0 ? 2 : 4;
        const float g64 = ex2(64.0f * ret_lg(h));
        const bf16* va = P.RVT + ((size_t)bh * 128 + 32 * eb + r32) * LSEQ + key0 + 8 * hi;
        const bf16* kb = P.RKT + ((size_t)bh * 64 + 32 * db + r32) * LSEQ + key0 + 8 * hi;
        f32x16 acc = (f32x16){0.f, 0.f, 0.f, 0.f, 0.f, 0.f, 0.f, 0.f, 0.f, 0.f, 0.f, 0.f, 0.f, 0.f, 0.f, 0.f};
        for (int j = 0; j < ntile; ++j) {
            bf16x8 af[4], bfr[4];
#pragma unroll
            for (int s_ = 0; s_ < 4; ++s_) { af[s_] = *(const bf16x8*)(va + 64 * j + 16 * s_); bfr[s_] = *(const bf16x8*)(kb + 64 * j + 16 * s_); }
#pragma unroll
            for (int s_ = 0; s_ < 4; ++s_) acc = MFMA32(af[s_], bfr[s_], acc);
#pragma unroll
            for (int r = 0; r < 16; ++r) acc[r] *= g64;
        }
        float* dst = P.DT + ((size_t)job * 128 + 32 * eb) * 64 + 32 * db + r32;
#pragma unroll
        for (int r = 0; r < 16; ++r) dst[crow(r, hi) * 64] = acc[r];
    }
}
constexpr int UNITS_PER_LEVEL = 64 + 64 + 32, NUNITS = 17 * UNITS_PER_LEVEL;
__device__ __forceinline__ void phase(const Ptrs& P, LAS unsigned char* lds, unsigned* counter, bool do_store) {
    volatile LAS int* ubox = (volatile LAS int*)(lds + OFF_UNIT);
    for (;;) {
        if (threadIdx.x == 0) ubox[0] = (int)atomicAdd(counter, 1u);
        __syncthreads();
        const int i = __builtin_amdgcn_readfirstlane(ubox[0]);
        __syncthreads();
        if (i >= NUNITS) break;
        const int lvl = i / UNITS_PER_LEVEL, j = i % UNITS_PER_LEVEL, u = 16 - lvl;
        if (j < 64) unit<1>(P, j, u, lds, do_store);
        else if (j < 128) unit<0>(P, j - 64, u, lds, do_store);
        else unit<2>(P, j - 128, u, lds, do_store);
    }
}
}

template <int MODE>
__device__ __forceinline__ void colmap(int p, int& src, float& sc) {
    sc = 1.f; src = p;
    if (MODE == 1) {
        if (p < 1536) { if (p < 512) sc = 0.18033688011112042f; }
        else if (p < 2048) { const int c = (p - 1536) & 255, isk = (p >= 1792), bj = c >> 7, wc = (c >> 5) & 3, n = (c >> 4) & 1, i = c & 15;
            src = (isk ? 2464 : 2208) + 64 * (2 * bj + (wc >> 1)) + 32 * n + 16 * (wc & 1) + i; if (isk) sc = 0.125f; }
        else if (p < 2560) src = 2720 + (p - 2048);
        else if (p < 3072) src = 3232 + (p - 2560);
        else if (p < 3328) src = 1920 + (p - 3072);
        else if (p < 3712) src = 1536 + (p - 3328);
        else if (p < 3744) src = 2176 + (p - 3712);
        else src = -1;
    } else if (MODE == 2) {
        sc = 0.14724444602590306f;
        if (p < 512) src = (p >> 6) * 96 + (p & 63); else { const int q = p - 512; src = (q >> 5) * 96 + 64 + (q & 31); }
    } else if (MODE == 3) {
        if (p < 512) src = (p >> 6) * 128 + (p & 63); else { const int q = p - 512; src = (q >> 6) * 128 + 64 + (q & 63); }
    }
}
template <int MODE>
__device__ __forceinline__ void conv_item(const float* W, int K, int Nsrc, int Nphys, const float* gain, bf16* WT, LAS float* scr, int item, int lane) {
    const int nblk = Nphys / 32, kb = item / nblk, nb = item % nblk, k0 = 64 * kb, n0 = 32 * nb;
    int src; float sc; colmap<MODE>(n0 + (lane & 31), src, sc);
#pragma unroll 8
    for (int i = 0; i < 32; ++i) { const int kk = 2 * i + (lane >> 5); float v = 0.f;
        if (src >= 0) { v = W[(size_t)(k0 + kk) * Nsrc + src] * sc; if (gain) v *= gain[k0 + kk]; }
        scr[kk * 33 + (lane & 31)] = v; }
    asm volatile("s_waitcnt lgkmcnt(0)" ::: "memory");
    const int c = lane & 7;
#pragma unroll
    for (int j = 0; j < 4; ++j) { const int n = (lane >> 3) + 8 * j; const LAS float* s = scr + (8 * c) * 33 + n;
        u32x4 o; o.x = cvtpk(s[0 * 33], s[1 * 33]); o.y = cvtpk(s[2 * 33], s[3 * 33]); o.z = cvtpk(s[4 * 33], s[5 * 33]); o.w = cvtpk(s[6 * 33], s[7 * 33]);
        *(u32x4*)(WT + (size_t)(n0 + n) * K + k0 + 8 * c) = o; }
    asm volatile("s_waitcnt lgkmcnt(0)" ::: "memory");
}
__device__ __forceinline__ void convert_weights(const Ptrs& P, int layer, LAS unsigned char* lds, int gw, int NGW, int wave, int lane) {
    LAS float* scr = (LAS float*)(lds + wave * 16384);
    constexpr int I_IN = 16 * (NIN / 32), I_UQ = 6 * 24, I_UKV = 4 * 32, I_OUT = 24 * 32, I_1 = 16 * 128, I_2 = 64 * 32, NIT = I_IN + I_UQ + I_UKV + I_OUT + I_1 + I_2;
    const float* w_in = P.in[4] + (size_t)layer * 1024 * NIN_LOG; const float* gq = P.in[5] + layer * 384; const float* gkv = P.in[6] + layer * 256;
    const float* w_uq = P.in[7] + (size_t)layer * 384 * 768; const float* w_ukv = P.in[8] + (size_t)layer * 256 * 1024; const float* w_out = P.in[9] + (size_t)layer * 1536 * 1024;
    const float* w1 = P.in[12] + (size_t)layer * 1024 * 4096; const float* w2 = P.in[13] + (size_t)layer * 4096 * 1024;
    for (int it = gw; it < NIT; it += NGW) {
        int r = it;
        if (r < I_IN) { conv_item<1>(w_in, 1024, NIN_LOG, NIN, nullptr, P.Win, scr, r, lane); continue; } r -= I_IN;
        if (r < I_UQ) { conv_item<2>(w_uq, 384, 768, 768, gq, P.Wuq, scr, r, lane); continue; } r -= I_UQ;
        if (r < I_UKV) { conv_item<3>(w_ukv, 256, 1024, 1024, gkv, P.Wukv, scr, r, lane); continue; } r -= I_UKV;
        if (r < I_OUT) { conv_item<0>(w_out, 1536, 1024, 1024, nullptr, P.Wout, scr, r, lane); continue; } r -= I_OUT;
        if (r < I_1) { conv_item<0>(w1, 1024, 4096, 4096, nullptr, P.W1, scr, r, lane); continue; } r -= I_1;
        conv_item<0>(w2, 4096, 1024, 1024, nullptr, P.W2, scr, r, lane);
    }
}
__device__ __forceinline__ void ln_regs(f32x4 (&v)[4], const float* g, const float* bta, int lane) {
    float s = 0.f;
#pragma unroll
    for (int j = 0; j < 4; ++j) s += (v[j][0] + v[j][1]) + (v[j][2] + v[j][3]);
    const float mean = wave_sum(s) * (1.f / DM); float s2 = 0.f;
#pragma unroll
    for (int j = 0; j < 4; ++j) { v[j] = v[j] - mean; s2 += (v[j][0] * v[j][0] + v[j][1] * v[j][1]) + (v[j][2] * v[j][2] + v[j][3] * v[j][3]); }
    const float rstd = 1.f / sqrtf(wave_sum(s2) * (1.f / DM) + LN_EPS);
#pragma unroll
    for (int j = 0; j < 4; ++j) { const f32x4 gg = ((const f32x4*)g)[64 * j + lane], bb = ((const f32x4*)bta)[64 * j + lane]; v[j] = v[j] * rstd * gg + bb; }
}
__device__ __forceinline__ void store_h_hb(const Ptrs& P, int row, const f32x4 (&v)[4], int lane, bool write_h) {
#pragma unroll
    for (int j = 0; j < 4; ++j) {
        if (write_h) ((f32x4*)(P.H + (size_t)row * DM))[64 * j + lane] = v[j];
        u32x2 w; w.x = cvtpk(v[j][0], v[j][1]); w.y = cvtpk(v[j][2], v[j][3]); ((u32x2*)(P.HB + (size_t)row * DM))[64 * j + lane] = w; }
}
__device__ __forceinline__ void phase_prep(const Ptrs& P, LAS unsigned char* lds, int gw, int NGW, int wave, int lane) {
    convert_weights(P, 0, lds, gw, NGW, wave, lane);
    const int gt = gw * 64 + lane, NGT = NGW * 64;
    for (int i = gt; i < LSEQ * 48; i += NGT) {
        const int t = i / 48, k = i % 48; const float pos = (float)(t - NPAD);
        const float inv = (k < 32) ? ex2(-(float)k * (13.287712379549449f / 32.0f)) : ex2(-(float)(k - 32) * (13.287712379549449f / 16.0f));
        const float ang = pos * inv;
        double rev = (double)ang * 0.15915494309189535; rev -= floor(rev); const float fr = (float)rev;
        const f32x2 cs = {__builtin_amdgcn_cosf(fr), __builtin_amdgcn_sinf(fr)};
        if (k < 32) P.tab64[(size_t)t * 32 + k] = cs; else P.tab32[(size_t)t * 16 + (k - 32)] = cs;
    }
    const float* x = P.in[0]; const float* meta = P.in[1]; const float* g = P.in[2]; const float* bta = P.in[3];
    for (int row = gw; row < MROWS; row += NGW) {
        const int b = row / LSEQ, t = row - b * LSEQ; f32x4 v[4];
#pragma unroll
        for (int j = 0; j < 4; ++j) {
            if (t < NPAD) v[j] = (f32x4){0.f, 0.f, 0.f, 0.f};
            else if (t < 128) v[j] = ((const f32x4*)(meta + (size_t)(t - NPAD) * DM))[64 * j + lane];
            else v[j] = ((const f32x4*)(x + ((size_t)b * SEQ + (t - 128)) * DM))[64 * j + lane]; }
        ln_regs(v, g, bta, lane);
        store_h_hb(P, row, v, lane, true);
    }
}
__device__ __forceinline__ void ln_store(const Ptrs& P, int row, const f32x4 (&v)[4], int lane, bool final_out) {
    if (!final_out) store_h_hb(P, row, v, lane, true);
    else { const int b = row / LSEQ, t = row - b * LSEQ;
        if (t >= 128) {
#pragma unroll
            for (int j = 0; j < 4; ++j) ((f32x4*)(P.out + ((size_t)b * SEQ + (t - 128)) * DM))[64 * j + lane] = v[j]; } }
}
__device__ __forceinline__ void phase_ln(const Ptrs& P, const bf16* T, const float* g, const float* bta, bool final_out, int gw, int NGW, int lane) {
    int row = gw;
    for (; row + NGW < TAIL_ROW0; row += 2 * NGW) {
        f32x4 va[4], vb[4];
#pragma unroll
        for (int j = 0; j < 4; ++j) { va[j] = ((const f32x4*)(P.H + (size_t)row * DM))[64 * j + lane]; vb[j] = ((const f32x4*)(P.H + (size_t)(row + NGW) * DM))[64 * j + lane]; }
        if (T) {
#pragma unroll
            for (int j = 0; j < 4; ++j) { const u32x2 t0 = ((const u32x2*)(T + (size_t)row * DM))[64 * j + lane], t1 = ((const u32x2*)(T + (size_t)(row + NGW) * DM))[64 * j + lane];
                va[j] = va[j] * DN_ALPHA + (f32x4){__builtin_bit_cast(float, t0.x << 16), __builtin_bit_cast(float, t0.x & 0xffff0000u), __builtin_bit_cast(float, t0.y << 16), __builtin_bit_cast(float, t0.y & 0xffff0000u)};
                vb[j] = vb[j] * DN_ALPHA + (f32x4){__builtin_bit_cast(float, t1.x << 16), __builtin_bit_cast(float, t1.x & 0xffff0000u), __builtin_bit_cast(float, t1.y << 16), __builtin_bit_cast(float, t1.y & 0xffff0000u)}; }
        }
        ln_regs(va, g, bta, lane); ln_regs(vb, g, bta, lane);
        ln_store(P, row, va, lane, final_out); ln_store(P, row + NGW, vb, lane, final_out);
    }
    for (; row < MROWS; row += NGW) {
        f32x4 v[4];
#pragma unroll
        for (int j = 0; j < 4; ++j) v[j] = ((const f32x4*)(P.H + (size_t)row * DM))[64 * j + lane];
        if (row >= TAIL_ROW0) {
            const float* part = (const float*)(P.ws + WS_PART) + (size_t)(row - TAIL_ROW0) * DM;
#pragma unroll
            for (int j = 0; j < 4; ++j) { f32x4 sacc = ((const f32x4*)part)[64 * j + lane];
#pragma unroll
                for (int ks = 1; ks < NSPLIT; ++ks) sacc += ((const f32x4*)(part + (size_t)ks * 1024 * 1024))[64 * j + lane];
                v[j] = v[j] * DN_ALPHA + sacc; }
        }
        ln_regs(v, g, bta, lane);
        if (!final_out) store_h_hb(P, row, v, lane, true);
        else { const int b = row / LSEQ, t = row - b * LSEQ;
            if (t >= 128) {
#pragma unroll
                for (int j = 0; j < 4; ++j) ((f32x4*)(P.out + ((size_t)b * SEQ + (t - 128)) * DM))[64 * j + lane] = v[j]; } }
    }
}

#define XB_TMO      128
#define XB_XCNT(j)  (256  + 64 * (j))
#define XB_XSUB(j)  (1280 + 64 * (j))
#define XB_XGEN(j)  (2304 + 64 * (j))
#define XB_TOP      3328
#define XB_TOPGEN   3392
#define XCD_BAR_WORDS 3456
#define XB_SPIN_CAP (1u << 18)

__device__ __forceinline__ unsigned xb_ld(unsigned* p)              { return __hip_atomic_load(p, __ATOMIC_RELAXED, __HIP_MEMORY_SCOPE_AGENT); }
__device__ __forceinline__ unsigned xb_add(unsigned* p, unsigned v) { return __hip_atomic_fetch_add(p, v, __ATOMIC_RELAXED, __HIP_MEMORY_SCOPE_AGENT); }
__device__ __forceinline__ unsigned xb_xcc_id() { return (unsigned)__builtin_amdgcn_s_getreg((3 << 11) | 20) & 0xFu; }
#define XB_SPIN(cond, bar) do { unsigned _sp = 0; while (cond) { __builtin_amdgcn_s_sleep(1); \
    if ((++_sp & 255u) == 0u) { if (xb_ld(&(bar)[XB_TMO])) break; if (_sp > XB_SPIN_CAP) { atomicAdd(&(bar)[XB_TMO], 1u); break; } } } } while (0)

struct XcdBarrier {
    unsigned* bar; unsigned x;
    volatile LAS unsigned* st;
};

__device__ __forceinline__ XcdBarrier xcd_barrier_post(unsigned* bar, volatile LAS unsigned* st) {
    XcdBarrier b; b.bar = bar; b.x = xb_xcc_id(); b.st = st;
    if (threadIdx.x == 0) (void)xb_add(&bar[XB_XCNT(b.x)], 1u);
    return b;
}
__device__ __forceinline__ void xcd_barrier_complete(unsigned* bar, unsigned x, unsigned& nloc, unsigned& nx) {
    const unsigned G = gridDim.x * gridDim.y * gridDim.z;
    unsigned sum, cnt, mine, sp = 0u;
    for (;;) {
        sum = 0u; cnt = 0u; mine = 0u;
#pragma unroll
        for (unsigned j = 0; j < 16; ++j) { const unsigned c = xb_ld(&bar[XB_XCNT(j)]); sum += c; cnt += (c > 0u) ? 1u : 0u; mine = (j == x) ? c : mine; }
        if (sum == G) break;
        __builtin_amdgcn_s_sleep(1);
        if ((++sp & 255u) == 0u) { if (xb_ld(&bar[XB_TMO])) break; if (sp > XB_SPIN_CAP) { atomicAdd(&bar[XB_TMO], 1u); break; } }
    }
    nloc = mine > 0u ? mine : 1u; nx = cnt > 0u ? cnt : 1u;
}

__device__ __forceinline__ void xcd_barrier(const XcdBarrier& b) {
    asm volatile("s_waitcnt vmcnt(0)" ::: "memory");
    __syncthreads();
    if (threadIdx.x == 0) {
        unsigned* bar = b.bar;
        __builtin_amdgcn_s_waitcnt(0);
        unsigned nloc = b.st[0], nx = b.st[1];
        if (nloc == 0u) { xcd_barrier_complete(bar, b.x, nloc, nx); b.st[0] = nloc; b.st[1] = nx; }
        const unsigned old = xb_add(&bar[XB_XSUB(b.x)], 1u);
        const unsigned gen = old / nloc;
        if (old + 1u == (gen + 1u) * nloc) {
            __builtin_amdgcn_fence(__ATOMIC_RELEASE, "agent");
            asm volatile("s_waitcnt vmcnt(0)" ::: "memory");
            const unsigned og = xb_add(&bar[XB_TOP], 1u);
            const unsigned tg = og / nx;
            if (og + 1u == (tg + 1u) * nx) xb_add(&bar[XB_TOPGEN], 1u);
            else XB_SPIN(xb_ld(&bar[XB_TOPGEN]) == tg, bar);
            __builtin_amdgcn_fence(__ATOMIC_ACQUIRE, "agent");
            xb_add(&bar[XB_XGEN(b.x)], 1u);
            asm volatile("s_waitcnt vmcnt(0)" ::: "memory");
        } else {
            XB_SPIN(xb_ld(&bar[XB_XGEN(b.x)]) == gen, bar);
            __builtin_amdgcn_fence(__ATOMIC_ACQUIRE, "agent");
            asm volatile("s_waitcnt vmcnt(0)" ::: "memory");
        }
    }
    __syncthreads();
}

struct Args { const float* in[16]; float* out; unsigned char* ws; int ph_lo, ph_hi; };
static_assert(sizeof(Args) == 16 * 8 + 8 + 8 + 8, "Args has no padding");

template <class Epi>
__device__ __forceinline__ void run_gemm(LAS unsigned char* lds, const bf16* A, const bf16* Bt, int N, int K, const Epi& E, int rot = 0) {
    pg8::Gemm g{A, Bt, MROWS, N, K, K}; pg8::StaticOrder S; S.init(MROWS, N, (int)gridDim.x, ((int)blockIdx.x + rot) % (int)gridDim.x);
    pg8::gemm_phase<Epi, pg8::StaticOrder, true, true>(lds, g, S, E);
}
__device__ __forceinline__ void run_gemm_res(LAS unsigned char* lds, const bf16* A, const bf16* Bt, int K, float* H, float* PART, bf16* T) {
    const int rot = ((int)blockIdx.x + 128) % (int)gridDim.x;
    { EpiPart E{PART, K / 64 / NSPLIT}; pg8::Gemm g{A, Bt, MROWS, 1024, K / NSPLIT, K}; TailOrder S{(int)gridDim.x, rot, K / 64 / NSPLIT};
      pg8::gemm_phase<EpiPart, TailOrder, true, true>(lds, g, S, E); }
    if (T) { EpiResT E{T}; pg8::Gemm g{A, Bt, TAIL_ROW0, 1024, K, K}; pg8::StaticOrder S; S.init(TAIL_ROW0, 1024, (int)gridDim.x, (int)blockIdx.x);
      pg8::gemm_phase<EpiResT, pg8::StaticOrder, true, true>(lds, g, S, E); }
    else { EpiRes E{H}; pg8::Gemm g{A, Bt, TAIL_ROW0, 1024, K, K}; pg8::StaticOrder S; S.init(TAIL_ROW0, 1024, (int)gridDim.x, (int)blockIdx.x);
      pg8::gemm_phase<EpiRes, pg8::StaticOrder, true, true>(lds, g, S, E); }
}

__global__ void __launch_bounds__(NTHREADS, 2) mk_fwd(Args a) {
    extern __shared__ __attribute__((aligned(16))) unsigned char lds_raw[];
    LAS unsigned char* lds = (LAS unsigned char*)lds_raw;
    volatile LAS unsigned* MISC = (volatile LAS unsigned*)(lds + 143360);
    if (threadIdx.x < 32) MISC[threadIdx.x] = 0u;
    __syncthreads();
    XcdBarrier xbar = xcd_barrier_post((unsigned*)(a.ws + WS_MISC + MISC_CTL) + 4096, MISC + 8);
    for (int ph = a.ph_lo; ph < a.ph_hi; ++ph) {
        int tid_l = threadIdx.x; asm volatile("" : "+v"(tid_l));
        const int tid = tid_l, lane = tid & 63, wave = __builtin_amdgcn_readfirstlane(tid >> 6);
        const int gw = (int)blockIdx.x * NWAVES + wave, NGW = (int)gridDim.x * NWAVES;
    size_t zoff = 0; asm volatile("" : "+s"(zoff));
    Ptrs P;
#pragma unroll
    for (int i = 0; i < 16; ++i) P.in[i] = a.in[i] + zoff;
    unsigned char* wsl = a.ws + zoff; float* outl = a.out + zoff;
    fill_ptrs(P, wsl, outl);
        if (ph == 0) phase_prep(P, lds, gw, NGW, wave, lane);
        else {
            const int l = (ph - 1) >> 3, s = (ph - 1) & 7;
            if (s == 0) {
#ifndef NO_IN
 EpiIn E{wsl, outl, l}; run_gemm(lds, P.HB, P.Win, NIN, 1024, E);
#endif
 }
            else if (s == 1) {
#ifndef NO_U
 { EpiUq E{wsl, outl, l}; run_gemm(lds, P.CQ, P.Wuq, 768, 384, E); } { EpiUkv E{wsl, outl, l}; run_gemm(lds, P.CKV, P.Wukv, 1024, 256, E, 104); }
 att::ret_state_jobs(P);
#endif
 }
            else if (s == 2) {
#ifndef NO_ATT
#ifdef PROBE_ATT
 const int nrep = 2 + (int)P.ctl[1];
#else
 const int nrep = 1;
#endif
 for (int rep = 0; rep < nrep; ++rep) att::phase(P, lds, P.ctl + 64 * (l + 1 + 8 * rep), rep == nrep - 1);
#endif
 }
            else if (s == 3) {
#ifndef NO_RES
 run_gemm_res(lds, P.MIX, P.Wout, 1536, P.H, (float*)(wsl + WS_PART), ((TMASK >> (2 * l)) & 1) ? P.HB : nullptr);
#endif
 }
            else if (s == 4) phase_ln(P, ((TMASK >> (2 * l)) & 1) ? P.HB : nullptr, P.in[10] + l * DM, P.in[11] + l * DM, false, gw, NGW, lane);
            else if (s == 5) {
#ifndef NO_FF
 EpiFf1 E{P.U};
#ifdef PROBE_FF1
 const int nrep1 = 2 + (int)P.ctl[1];
#else
 const int nrep1 = 1;
#endif
 for (int rep = 0; rep < nrep1; ++rep) run_gemm(lds, P.HB, P.W1, 4096, 1024, E);
#endif
 }
            else if (s == 6) {
#ifndef NO_RES
 run_gemm_res(lds, P.U, P.W2, 4096, P.H, (float*)(wsl + WS_PART), ((TMASK >> (2 * l + 1)) & 1) ? P.HB : nullptr);
#endif
 }
            else { if (l + 1 < DEPTH) convert_weights(P, l + 1, lds, gw, NGW, wave, lane);
                   phase_ln(P, ((TMASK >> (2 * l + 1)) & 1) ? P.HB : nullptr, P.in[14] + l * DM, P.in[15] + l * DM, l + 1 == DEPTH, gw, NGW, lane); }
        }
#ifndef T_NOSYNC
        if (ph + 1 < a.ph_hi) { if (ph == a.ph_lo) cg::this_grid().sync(); else xcd_barrier(xbar); }
#ifdef PROBE_SYNC
        if (ph + 1 < a.ph_hi) { cg::this_grid().sync(); cg::this_grid().sync(); }
#endif
#endif
    }
}

extern "C" void kernel_launch(void* const* d_in, const int* in_sizes, int n_in, void* d_out, int out_size, void* d_ws, size_t ws_size, hipStream_t stream) {
    static int grid = 0;
    if (grid == 0) {
        if (n_in != 16 || in_sizes[0] != BATCH * SEQ * DM || out_size != BATCH * SEQ * DM || ws_size < WS_END) {
            fprintf(stderr, "kernel_launch: unexpected shapes (n_in %d, in0 %d, out %d, ws %zu, need %zu); nothing launched\n", n_in, n_in > 0 ? in_sizes[0] : -1, out_size, ws_size, (size_t)WS_END); grid = -1; return; }
        int dev = 0, cus = 0, per_cu = 0;
        if (hipGetDevice(&dev) != hipSuccess || hipDeviceGetAttribute(&cus, hipDeviceAttributeMultiprocessorCount, dev) != hipSuccess) { grid = -1; return; }
        if (hipFuncSetAttribute((const void*)mk_fwd, hipFuncAttributeMaxDynamicSharedMemorySize, LDS_BYTES) != hipSuccess) { fprintf(stderr, "kernel_launch: hipFuncSetAttribute failed\n"); grid = -1; return; }
        if (hipOccupancyMaxActiveBlocksPerMultiprocessor(&per_cu, (const void*)mk_fwd, NTHREADS, LDS_BYTES) != hipSuccess || per_cu < 1) { fprintf(stderr, "kernel_launch: occupancy query says %d\n", per_cu); per_cu = 1; }
        (void)hipGetLastError();
        grid = cus * 1;
    }
    if (grid < 0) return;
    (void)hipMemsetAsync((char*)d_ws + WS_MISC + MISC_CTL, 0, CTL_BYTES, stream);
    Args a{};
    for (int i = 0; i < 16; ++i) a.in[i] = (const float*)d_in[i];
    a.out = (float*)d_out; a.ws = (unsigned char*)d_ws;
#if MK_SPLIT
    for (int ph = 0; ph < NPHASES; ++ph) { a.ph_lo = ph; a.ph_hi = ph + 1; hipLaunchKernelGGL(mk_fwd, dim3(grid), dim3(NTHREADS), LDS_BYTES, stream, a); }
#else
    a.ph_lo = 0; a.ph_hi = NPHASES;
    void* args[] = {&a};
    hipError_t e = hipLaunchCooperativeKernel((const void*)mk_fwd, dim3(grid), dim3(NTHREADS), args, LDS_BYTES, stream);
    if (e != hipSuccess) fprintf(stderr, "kernel_launch: cooperative launch failed: %s (grid %d)\n", hipGetErrorString(e), grid);
#endif
}
```

```cpp
#define TMASK 255
#include <hip/hip_runtime.h>
#include <hip/hip_cooperative_groups.h>
#include <cstdio>
#include <cstdint>
namespace cg = cooperative_groups;
#ifndef TMASK
#define TMASK 0
#endif
#ifndef MK_SPLIT
#define MK_SPLIT 0
#endif
namespace pg8 {
#define PG8_LAS __attribute__((address_space(3)))
typedef unsigned short bf16_t;
typedef short bf16x8 __attribute__((ext_vector_type(8)));
typedef float f32x4 __attribute__((ext_vector_type(4)));
typedef unsigned u32x4 __attribute__((ext_vector_type(4)));
constexpr int BM = 256, BK = 64, HALF = 128, HTB = HALF * BK * 2  , STAGE_BYTES = 8 * HTB, NXCD = 8, WGM = 8;

__host__ __device__ __forceinline__ int lds_byte(int r, int c) { const int st = (r >> 4) * 2 + (c >> 5), rr = r & 15, cc = c & 31, ob = rr * 64 + cc * 2; return st * 1024 + (ob ^ (((ob >> 9) & 1) << 5)); }
__host__ __device__ __forceinline__ void stage_rc(int b, int& R, int& C) { const int st = b / 1024, sb = b % 1024, swz = sb ^ (((sb >> 9) & 1) << 5); R = (st >> 1) * 16 + swz / 64; C = (st & 1) * 32 + (swz % 64) / 2; }
__host__ __device__ __forceinline__ int perm32(int rho) { const int n = rho >> 4, i = rho & 15; return 8 * (i >> 2) + 4 * n + (i & 3); }

struct Unit { int pm, pn, kt0; };
struct Gemm { const bf16_t* A; const bf16_t* Bt; int M, N, K, ld; };

struct StaticOrder {
    int nM, nN, nwg, G, c;
    __host__ __device__ void init(int M, int N, int G_, int c_) { nM = M / BM; nN = N / BM; nwg = nM * nN; G = G_; c = c_; }
    __host__ __device__ bool next(int i, Unit& u) const {
        const long L = (long)i * G + c; if (L >= nwg) return false;
        int wgid = (int)L; { const int q = nwg / NXCD, r = nwg % NXCD, xcd = wgid % NXCD, off = wgid / NXCD; wgid = (xcd < r ? xcd * (q + 1) : r * (q + 1) + (xcd - r) * q) + off; }
        const int nig = WGM * nN, gid = wgid / nig, fm = gid * WGM, gsz = (nM - fm) < WGM ? (nM - fm) : WGM;
        u.pm = fm + ((wgid % nig) % gsz); u.pn = (wgid % nig) / gsz; u.kt0 = 0; return true;
    }
    __device__ __forceinline__ void a_ready(const Unit&) const {}
    __device__ __forceinline__ void done(const Unit&) const {}
};
template <class Epi, class Sched, bool ALIGN_EPI = false, bool SP2 = false>
__device__ __forceinline__ void gemm_phase(PG8_LAS unsigned char* lds, const Gemm g, const Sched& S, const Epi& E) {
    int tid_l = threadIdx.x; asm volatile("" : "+v"(tid_l));
    const int tid = tid_l, wid = __builtin_amdgcn_readfirstlane(tid >> 6), lane = tid & 63, wr = wid >> 2, wc = wid & 3, fr = lane & 15, fq = lane >> 4;
    const int K = g.K, nt = K / BK;
    unsigned voffA[2], voffB[2];
#pragma unroll
    for (int i = 0; i < 2; ++i) { int R, C; stage_rc(tid * 16 + i * 8192, R, C); const int Rb = Epi::PERM ? ((R & ~31) + perm32(R & 31)) : R;
        voffA[i] = (unsigned)(R * g.ld + C) * 2u; voffB[i] = (unsigned)(Rb * g.ld + C) * 2u; }
    const size_t kstep = (size_t)(BK * 2);
    const size_t hstep = (size_t)HALF * g.ld * 2;
    const size_t tstep = 2 * hstep;
    const unsigned ldsw = (unsigned)wid * 1024u;
    const int aoff = lds_byte(wr * 64 + fr, fq * 8), boff = lds_byte(wc * 32 + fr, fq * 8);
#define PG8_SA(b, h) (((b) * 2 + (h)) * HTB)
#define PG8_SB(b, h) ((4 + (b) * 2 + (h)) * HTB)
#define PG8_STAGE(bufoff, gbase, voff) do { _Pragma("unroll") for (int _i = 0; _i < 2; ++_i) \
        __builtin_amdgcn_global_load_lds((const unsigned*)((const char*)(gbase) + (voff)[_i]), (PG8_LAS unsigned*)(lds + (bufoff) + ldsw + _i * 8192), 16, 0, 0); } while (0)
#define PG8_LDA(dst, b, h) do { _Pragma("unroll") for (int m = 0; m < 4; ++m) _Pragma("unroll") for (int k = 0; k < 2; ++k) dst[m][k] = *(const PG8_LAS bf16x8*)(lds + PG8_SA(b, h) + aoff + m * 2048 + k * 1024); } while (0)
#define PG8_LDB(dst, b, h) do { _Pragma("unroll") for (int n = 0; n < 2; ++n) _Pragma("unroll") for (int k = 0; k < 2; ++k) dst[n][k] = *(const PG8_LAS bf16x8*)(lds + PG8_SB(b, h) + boff + n * 2048 + k * 1024); } while (0)
#define PG8_MMA(ai, bj, At, Bt) do { __builtin_amdgcn_s_setprio(1); _Pragma("unroll") for (int m = 0; m < 4; ++m) _Pragma("unroll") for (int n = 0; n < 2; ++n) _Pragma("unroll") for (int k = 0; k < 2; ++k) \
        acc[ai][bj][m][n] = __builtin_amdgcn_mfma_f32_16x16x32_bf16(Bt[n][k], At[m][k], acc[ai][bj][m][n], 0, 0, 0); __builtin_amdgcn_s_setprio(0); } while (0)
#define PG8_WAIT_V(n) asm volatile("s_waitcnt vmcnt(" #n ")" ::: "memory")
#define PG8_WAIT_L(n) asm volatile("s_waitcnt lgkmcnt(" #n ")" ::: "memory")
#define PG8_BAR __builtin_amdgcn_s_barrier()
#define PG8_SCHED __builtin_amdgcn_sched_barrier(0)
    Unit cur, nxt; int ui = 0;
    if (!S.next(0, cur)) return;
    f32x4 acc[2][2][4][2];
#pragma unroll
    for (int a = 0; a < 2; ++a)
#pragma unroll
        for (int b = 0; b < 2; ++b)
#pragma unroll
            for (int m = 0; m < 4; ++m)
#pragma unroll
                for (int n = 0; n < 2; ++n) acc[a][b][m][n] = (f32x4){0.f, 0.f, 0.f, 0.f};
    bf16x8 At[4][2], B0[2][2], B1[2][2];
    const char* cA = (const char*)g.A + (size_t)cur.pm * tstep + (size_t)cur.kt0 * kstep; const char* cB = (const char*)g.Bt + (size_t)cur.pn * tstep + (size_t)cur.kt0 * kstep;
    S.a_ready(cur);
    if constexpr (SP2) {
        PG8_STAGE(PG8_SB(0, 0), cB, voffB); PG8_STAGE(PG8_SB(0, 1), cB + hstep, voffB); PG8_STAGE(PG8_SA(0, 0), cA, voffA); PG8_STAGE(PG8_SA(0, 1), cA + hstep, voffA);
        if (wr == 1) PG8_BAR;
        PG8_WAIT_V(2); PG8_BAR;
        PG8_STAGE(PG8_SB(1, 0), cB + kstep, voffB); PG8_STAGE(PG8_SA(1, 0), cA + kstep, voffA); PG8_STAGE(PG8_SB(1, 1), cB + hstep + kstep, voffB);
        PG8_WAIT_V(6); PG8_BAR;
    } else {
        PG8_STAGE(PG8_SB(0, 0), cB, voffB); PG8_STAGE(PG8_SA(0, 0), cA, voffA); PG8_STAGE(PG8_SB(0, 1), cB + hstep, voffB); PG8_STAGE(PG8_SA(0, 1), cA + hstep, voffA);
        if (wr == 1) PG8_BAR;
        PG8_WAIT_V(4); PG8_BAR;
        PG8_STAGE(PG8_SB(1, 0), cB + kstep, voffB); PG8_STAGE(PG8_SA(1, 0), cA + kstep, voffA); PG8_STAGE(PG8_SB(1, 1), cB + hstep + kstep, voffB);
        PG8_WAIT_V(6); PG8_BAR;
    }
    for (;;) {
        const bool has_next = S.next(ui + 1, nxt);
        const char* nA = has_next ? (const char*)g.A + (size_t)nxt.pm * tstep + (size_t)nxt.kt0 * kstep : cA; const char* nB = has_next ? (const char*)g.Bt + (size_t)nxt.pn * tstep + (size_t)nxt.kt0 * kstep : cB;
        for (int t = 0; t < nt; t += 2) {
            const bool last = (t == nt - 2);
            const char* a1 = cA + (size_t)(t + 1) * kstep;
            const char* a2 = last ? nA : cA + (size_t)(t + 2) * kstep; const char* b2 = last ? nB : cB + (size_t)(t + 2) * kstep;
            const char* a3 = a2 + kstep; const char* b3 = b2 + kstep;
            if (last && has_next) S.a_ready(nxt);
            if constexpr (SP2) {
            PG8_LDB(B0, 0, 0); PG8_LDB(B1, 0, 1); PG8_SCHED; PG8_LDA(At, 0, 0); PG8_STAGE(PG8_SA(1, 1), a1 + hstep, voffA);
            PG8_WAIT_V(8); PG8_WAIT_L(0); PG8_BAR; PG8_MMA(0, 0, At, B0); PG8_MMA(0, 1, At, B1); PG8_BAR; PG8_SCHED;
            PG8_LDA(At, 0, 1); PG8_STAGE(PG8_SB(0, 0), b2, voffB); PG8_STAGE(PG8_SB(0, 1), b2 + hstep, voffB); PG8_STAGE(PG8_SA(0, 0), a2, voffA);
            PG8_WAIT_V(8); PG8_WAIT_L(0); PG8_BAR; PG8_MMA(1, 0, At, B0); PG8_MMA(1, 1, At, B1); PG8_BAR; PG8_SCHED;
            PG8_LDB(B0, 1, 0); PG8_LDB(B1, 1, 1); PG8_SCHED; PG8_LDA(At, 1, 0); PG8_STAGE(PG8_SA(0, 1), a2 + hstep, voffA);
            PG8_WAIT_V(8); PG8_WAIT_L(0); PG8_BAR; PG8_MMA(0, 0, At, B0); PG8_MMA(0, 1, At, B1); PG8_BAR; PG8_SCHED;
            PG8_LDA(At, 1, 1); PG8_STAGE(PG8_SB(1, 0), b3, voffB); PG8_STAGE(PG8_SB(1, 1), b3 + hstep, voffB); PG8_STAGE(PG8_SA(1, 0), a3, voffA);
            PG8_WAIT_V(8); PG8_WAIT_L(0); PG8_BAR; PG8_MMA(1, 0, At, B0); PG8_MMA(1, 1, At, B1); PG8_BAR; PG8_SCHED;
            } else {
            PG8_LDB(B0, 0, 0); PG8_SCHED; PG8_LDA(At, 0, 0); PG8_STAGE(PG8_SA(1, 1), a1 + hstep, voffA);
            PG8_WAIT_L(8); PG8_BAR; PG8_WAIT_L(0); PG8_MMA(0, 0, At, B0); PG8_BAR; PG8_SCHED;
            PG8_LDB(B1, 0, 1); PG8_STAGE(PG8_SB(0, 0), b2, voffB);
            PG8_BAR; PG8_WAIT_L(0); PG8_MMA(0, 1, At, B1); PG8_BAR;
            PG8_LDA(At, 0, 1); PG8_STAGE(PG8_SA(0, 0), a2, voffA);
            PG8_BAR; PG8_WAIT_L(0); PG8_MMA(1, 0, At, B0); PG8_BAR; PG8_SCHED;
            PG8_STAGE(PG8_SB(0, 1), b2 + hstep, voffB);
            PG8_WAIT_V(6); PG8_BAR; PG8_MMA(1, 1, At, B1); PG8_BAR;
            PG8_LDB(B0, 1, 0); PG8_SCHED; PG8_LDA(At, 1, 0); PG8_STAGE(PG8_SA(0, 1), a2 + hstep, voffA);
            PG8_WAIT_L(8); PG8_BAR; PG8_WAIT_L(0); PG8_MMA(0, 0, At, B0); PG8_BAR; PG8_SCHED;
            PG8_LDB(B1, 1, 1); PG8_STAGE(PG8_SB(1, 0), b3, voffB);
            PG8_BAR; PG8_WAIT_L(0); PG8_MMA(0, 1, At, B1); PG8_BAR;
            PG8_LDA(At, 1, 1); PG8_STAGE(PG8_SA(1, 0), a3, voffA);
            PG8_BAR; PG8_WAIT_L(0); PG8_MMA(1, 0, At, B0); PG8_BAR; PG8_SCHED;
            PG8_STAGE(PG8_SB(1, 1), b3 + hstep, voffB);
            PG8_WAIT_V(6); PG8_BAR; PG8_MMA(1, 1, At, B1); PG8_BAR;
            }
        }
        if constexpr (ALIGN_EPI) { if (wr == 0) PG8_BAR; }
        if constexpr (!Epi::AFTER_DRAIN) { E(acc, cur, wr, wc, fr, fq); S.done(cur); }
        if (!has_next) break;
#pragma unroll
        for (int a = 0; a < 2; ++a)
#pragma unroll
            for (int b = 0; b < 2; ++b)
#pragma unroll
                for (int m = 0; m < 4; ++m)
#pragma unroll
                    for (int n = 0; n < 2; ++n) acc[a][b][m][n] = (f32x4){0.f, 0.f, 0.f, 0.f};
        cur = nxt; cA = nA; cB = nB; ++ui;
        if constexpr (ALIGN_EPI) { if (wr == 1) PG8_BAR; }
    }
    PG8_WAIT_V(0);
    if constexpr (!ALIGN_EPI) { if (wr == 0) PG8_BAR; }
    PG8_BAR;
    if constexpr (Epi::AFTER_DRAIN) { E.fused(acc, cur, wr, wc, fr, fq, lds, wid, lane); S.done(cur); }
#undef PG8_SA
#undef PG8_SB
#undef PG8_STAGE
#undef PG8_LDA
#undef PG8_LDB
#undef PG8_MMA
#undef PG8_WAIT_V
#undef PG8_WAIT_L
#undef PG8_BAR
#undef PG8_SCHED
}
}

constexpr int BATCH = 8, SEQ = 4096, DM = 1024, DEPTH = 4, NPAD = 112, LSEQ = 4224, MROWS = BATCH * LSEQ;
constexpr int NIN_LOG = 3744, NIN = 3840, DFF = 4096, DMIX = 1536;
constexpr float LN_EPS = 1e-5f, DN_ALPHA = 1.681792830507429f;
constexpr int NWAVES = 8, NTHREADS = 512;
constexpr int LDS_BYTES = 147456;
constexpr int NPHASES = 1 + 8 * DEPTH;

typedef unsigned short bf16;
typedef float f32x4 __attribute__((ext_vector_type(4)));
typedef float f32x2 __attribute__((ext_vector_type(2)));
typedef float f32x16 __attribute__((ext_vector_type(16)));
typedef short bf16x8 __attribute__((ext_vector_type(8)));
typedef unsigned u32x2 __attribute__((ext_vector_type(2)));
typedef unsigned u32x4 __attribute__((ext_vector_type(4)));
typedef __bf16 bf16x2_t __attribute__((ext_vector_type(2)));
#define LAS __attribute__((address_space(3)))

constexpr size_t MiB = 1u << 20;
constexpr size_t WS_H = 0, WS_HB = 132 * MiB, WS_W = 198 * MiB, WS_MISC = 226 * MiB, WS_B = 230 * MiB, WS_PART = 494 * MiB, WS_END = 510 * MiB;
constexpr size_t W_IN = 0, W_UQ = W_IN + (size_t)NIN * 1024 * 2, W_UKV = W_UQ + (size_t)768 * 384 * 2, W_OUT = W_UKV + (size_t)1024 * 256 * 2,
                 W_FF1 = W_OUT + (size_t)1024 * 1536 * 2, W_FF2 = W_FF1 + (size_t)4096 * 1024 * 2, W_TOTAL = W_FF2 + (size_t)1024 * 4096 * 2;
static_assert(W_TOTAL <= 28 * MiB, "weights region");
constexpr size_t MISC_CTL = 0, CTL_BYTES = 65536, MISC_TAB64 = 65536, MISC_TAB32 = MISC_TAB64 + (size_t)LSEQ * 32 * 8, MISC_SSQ = MISC_TAB32 + (size_t)LSEQ * 16 * 8,
                 MISC_END = MISC_SSQ + (size_t)12 * MROWS * 4;
static_assert(MISC_END <= 4 * MiB, "misc region");
constexpr size_t B_MIX = 0, B_KSB = 99 * MiB, B_VTSB = 132 * MiB, B_RQ = 165 * MiB, B_RK = B_RQ + 33 * MiB / 2, B_RVT = 198 * MiB, B_KN = 231 * MiB, B_U = 0;
constexpr size_t O_VTMLA = 0, O_CQ = 33 * MiB, O_CKV = O_CQ + (size_t)MROWS * 384 * 2, O_QR = O_CKV + (size_t)MROWS * 256 * 2, O_KR = O_QR + (size_t)MROWS * 256 * 2, O_END = O_KR + (size_t)MROWS * 32 * 2;
constexpr size_t O_DT = 93 * MiB, O_RKT = 109 * MiB;
static_assert(O_END <= O_DT && O_RKT + (size_t)MROWS * 256 * 2 <= 128 * MiB, "d_out scratch");

__device__ __forceinline__ unsigned f2bf(float f) { unsigned u = __builtin_bit_cast(unsigned, f); return (u + 0x7fffu + ((u >> 16) & 1u)) >> 16; }
__device__ __forceinline__ unsigned cvtpk(float lo, float hi) { f32x2 v = {lo, hi}; bf16x2_t b = __builtin_convertvector(v, bf16x2_t); return __builtin_bit_cast(unsigned, b); }
__device__ __forceinline__ float bf2f(unsigned short b) { return __builtin_bit_cast(float, (unsigned)b << 16); }
__device__ __forceinline__ float ex2(float x) { return __builtin_amdgcn_exp2f(x); }
__device__ __forceinline__ float wave_sum(float v) {
#pragma unroll
    for (int o = 1; o < 64; o <<= 1) v += __shfl_xor(v, o);
    return v;
}
__device__ __forceinline__ float ret_lg(int h) {
    return h == 0 ? -0.04580368961312479f : h == 1 ? -0.02272007650008353f : h == 2 ? -0.011315313227834146f : -0.005646563141142063f;
}

struct Ptrs {
    const float* in[16]; float* out; unsigned char* ws;
    float* H; bf16* HB; bf16* Win; bf16* Wuq; bf16* Wukv; bf16* Wout; bf16* W1; bf16* W2;
    unsigned* ctl; f32x2* tab64; f32x2* tab32; float* ssq;
    bf16 *MIX, *KSB, *VTSB, *RQ, *RK, *RVT, *KN, *U, *VTMLA, *CQ, *CKV, *QR, *KR, *RKT; float* DT;
};

#define GAS __attribute__((address_space(1)))
__device__ __forceinline__ void fill_ptrs(Ptrs& P, unsigned char* wsl_, float* outl_) {
    unsigned char* wsl = (unsigned char*)(GAS unsigned char*)wsl_; float* outl = (float*)(GAS float*)outl_;
    P.out = outl; P.ws = wsl;
    P.H = (float*)(wsl + WS_H); P.HB = (bf16*)(wsl + WS_HB);
    unsigned char* wb = wsl + WS_W;
    P.Win = (bf16*)(wb + W_IN); P.Wuq = (bf16*)(wb + W_UQ); P.Wukv = (bf16*)(wb + W_UKV); P.Wout = (bf16*)(wb + W_OUT); P.W1 = (bf16*)(wb + W_FF1); P.W2 = (bf16*)(wb + W_FF2);
    unsigned char* mb = wsl + WS_MISC;
    P.ctl = (unsigned*)(mb + MISC_CTL); P.tab64 = (f32x2*)(mb + MISC_TAB64); P.tab32 = (f32x2*)(mb + MISC_TAB32); P.ssq = (float*)(mb + MISC_SSQ);
    unsigned char* bb = wsl + WS_B;
    P.MIX = (bf16*)(bb + B_MIX); P.KSB = (bf16*)(bb + B_KSB); P.VTSB = (bf16*)(bb + B_VTSB); P.RQ = (bf16*)(bb + B_RQ); P.RK = (bf16*)(bb + B_RK); P.RVT = (bf16*)(bb + B_RVT);
    P.KN = (bf16*)(bb + B_KN); P.U = (bf16*)(bb + B_U);
    unsigned char* ob = (unsigned char*)outl;
    P.VTMLA = (bf16*)(ob + O_VTMLA); P.CQ = (bf16*)(ob + O_CQ); P.CKV = (bf16*)(ob + O_CKV); P.QR = (bf16*)(ob + O_QR); P.KR = (bf16*)(ob + O_KR); P.RKT = (bf16*)(ob + O_RKT); P.DT = (float*)(ob + O_DT);
}
#define EPI_PTRS Ptrs P; { size_t z_ = 0; asm volatile("" : "+s"(z_)); fill_ptrs(P, ws_ + z_, out_ + z_); } \
                 float* ssq_q = P.ssq; float* ssq_kv = P.ssq + (size_t)8 * MROWS; (void)ssq_q; (void)ssq_kv; (void)layer_;
using pg8::Unit;
#define EPI_ROWS_BEGIN  _Pragma("unroll") for (int ai = 0; ai < 2; ++ai) _Pragma("unroll") for (int m = 0; m < 4; ++m) { const int row = u.pm * 256 + ai * 128 + wr * 64 + m * 16 + fr; const int cl = wc * 32 + fq * 4; (void)cl;
#define EPI_ROWS_END    asm volatile("" ::: "memory"); }
#define EPI_COLS_BEGIN  _Pragma("unroll") for (int bj = 0; bj < 2; ++bj) _Pragma("unroll") for (int n = 0; n < 2; ++n) { const int co = bj * 128 + n * 16; const int c = co + cl; (void)c; const f32x4 v = acc[ai][bj][m][n];
#define EPI_COLS_END    }

__device__ __forceinline__ void st_bf4(bf16* p, f32x4 v) { u32x2 w; w.x = cvtpk(v[0], v[1]); w.y = cvtpk(v[2], v[3]); *(u32x2*)p = w; }

struct EpiIn {
    static constexpr bool PERM = false, AFTER_DRAIN = false;
    unsigned char* ws_; float* out_; int layer_;
    __device__ __forceinline__ void plain(const f32x4 (&acc)[2][2][4][2], const Unit& u, int wr, int wc, int fr, int fq, bf16* dst, int ld, int col0) const {
        EPI_ROWS_BEGIN
            bf16* rp = dst + (unsigned)(row * ld + col0 + cl);
            EPI_COLS_BEGIN st_bf4(rp + co, v); EPI_COLS_END
        EPI_ROWS_END
    }
    template <int HD> __device__ __forceinline__ void transposed(const f32x4 (&acc)[2][2][4][2], const Unit& u, int wr, int wc, int fr, int fq, bf16* dst, int cc0) const {
        constexpr int NH = 512 / HD;
        EPI_ROWS_BEGIN
            const int b = row / LSEQ, t = row - b * LSEQ;
            EPI_COLS_BEGIN
                const int cc = cc0 + c, head = cc / HD, d = cc % HD;
                bf16* q = dst + ((size_t)(b * NH + head) * HD + d) * LSEQ + t;
                q[0] = (bf16)f2bf(v[0]); q[LSEQ] = (bf16)f2bf(v[1]); q[2 * LSEQ] = (bf16)f2bf(v[2]); q[3 * LSEQ] = (bf16)f2bf(v[3]);
            EPI_COLS_END
        EPI_ROWS_END
    }
    __device__ __forceinline__ void withssq(const f32x4 (&acc)[2][2][4][2], const Unit& u, int wr, int wc, int fr, int fq, bf16* dst, int ld, int col0, float* ssq, int nbj, int nslot, int slot0) const {
        EPI_ROWS_BEGIN
            float s = 0.f; bf16* rp = dst + (unsigned)(row * ld + col0 + cl);
#pragma unroll
            for (int bj = 0; bj < 2; ++bj) if (bj < nbj) {
#pragma unroll
                for (int n = 0; n < 2; ++n) { const f32x4 v = acc[ai][bj][m][n];
                    st_bf4(rp + bj * 128 + n * 16, v); s += (v[0] * v[0] + v[1] * v[1]) + (v[2] * v[2] + v[3] * v[3]); } }
            s += __shfl_xor(s, 16); s += __shfl_xor(s, 32);
            if (fq == 0) ssq[(unsigned)(row * nslot + slot0 + wc)] = s;
        EPI_ROWS_END
    }
    template <bool ISK> __device__ __forceinline__ void rope64(const Ptrs& P, const f32x4 (&acc)[2][2][4][2], const Unit& u, int wr, int wc, int fr, int fq, bf16* dst) const {
        EPI_ROWS_BEGIN
            const int b = row / LSEQ, t = row - b * LSEQ; const int d0 = 16 * (wc & 1) + 4 * fq;
            const f32x4* tp = (const f32x4*)(P.tab64 + (size_t)t * 32 + d0); const f32x4 cs0 = tp[0], cs1 = tp[1];
#pragma unroll
            for (int bj = 0; bj < 2; ++bj) { const int hd = 2 * bj + (wc >> 1); const f32x4 x1 = acc[ai][bj][m][0], x2 = acc[ai][bj][m][1];
                float f;
                if (ISK) f = (t >= NPAD) ? ex2(-(float)(t & 63) * ret_lg(hd)) : 0.f; else f = ex2((float)(t & 31) * ret_lg(hd));
                f32x4 o1, o2;
                o1[0] = (x1[0] * cs0[0] - x2[0] * cs0[1]) * f; o2[0] = (x1[0] * cs0[1] + x2[0] * cs0[0]) * f;
                o1[1] = (x1[1] * cs0[2] - x2[1] * cs0[3]) * f; o2[1] = (x1[1] * cs0[3] + x2[1] * cs0[2]) * f;
                o1[2] = (x1[2] * cs1[0] - x2[2] * cs1[1]) * f; o2[2] = (x1[2] * cs1[1] + x2[2] * cs1[0]) * f;
                o1[3] = (x1[3] * cs1[2] - x2[3] * cs1[3]) * f; o2[3] = (x1[3] * cs1[3] + x2[3] * cs1[2]) * f;
                bf16* q = dst + (size_t)row * 256 + 64 * hd + d0; st_bf4(q, o1); st_bf4(q + 32, o2);
                if (ISK) { bf16* qt = P.RKT + ((size_t)(b * 4 + hd) * 64 + d0) * LSEQ + t;
#pragma unroll
                    for (int j = 0; j < 4; ++j) { qt[(size_t)j * LSEQ] = (bf16)f2bf(o1[j]); qt[(size_t)(32 + j) * LSEQ] = (bf16)f2bf(o2[j]); } } }
        EPI_ROWS_END
    }
    __device__ __forceinline__ void operator()(const f32x4 (&acc)[2][2][4][2], const Unit& u, int wr, int wc, int fr, int fq) const {
        const int pn = u.pn; EPI_PTRS
        if (pn < 2) plain(acc, u, wr, wc, fr, fq, P.MIX, DMIX, pn * 256);
        else if (pn < 4) plain(acc, u, wr, wc, fr, fq, P.KSB, 512, (pn - 2) * 256);
        else if (pn < 6) transposed<64>(acc, u, wr, wc, fr, fq, P.VTSB, (pn - 4) * 256);
        else if (pn == 6) rope64<false>(P, acc, u, wr, wc, fr, fq, P.RQ);
        else if (pn == 7) rope64<true>(P, acc, u, wr, wc, fr, fq, P.RK);
        else if (pn < 10) transposed<128>(acc, u, wr, wc, fr, fq, P.RVT, (pn - 8) * 256);
        else if (pn < 12) plain(acc, u, wr, wc, fr, fq, P.MIX, DMIX, 1024 + (pn - 10) * 256);
        else if (pn == 12) withssq(acc, u, wr, wc, fr, fq, P.CKV, 256, 0, ssq_kv, 2, 4, 0);
        else if (pn == 13) withssq(acc, u, wr, wc, fr, fq, P.CQ, 384, 0, ssq_q, 2, 8, 0);
        else {
            withssq(acc, u, wr, wc, fr, fq, P.CQ, 384, 256, ssq_q, 1, 8, 4);
            if (wc == 0) {
                EPI_ROWS_BEGIN
                    const int b = row / LSEQ, t = row - b * LSEQ;
                    const f32x4* tp = (const f32x4*)(P.tab32 + (size_t)t * 16 + 4 * fq); const f32x4 cs0 = tp[0], cs1 = tp[1];
                    const f32x4 x1 = acc[ai][1][m][0], x2 = acc[ai][1][m][1]; f32x4 o1, o2;
                    o1[0] = x1[0] * cs0[0] - x2[0] * cs0[1]; o2[0] = x1[0] * cs0[1] + x2[0] * cs0[0];
                    o1[1] = x1[1] * cs0[2] - x2[1] * cs0[3]; o2[1] = x1[1] * cs0[3] + x2[1] * cs0[2];
                    o1[2] = x1[2] * cs1[0] - x2[2] * cs1[1]; o2[2] = x1[2] * cs1[1] + x2[2] * cs1[0];
                    o1[3] = x1[3] * cs1[2] - x2[3] * cs1[3]; o2[3] = x1[3] * cs1[3] + x2[3] * cs1[2];
                    bf16* q = P.KR + (size_t)row * 32 + 4 * fq; st_bf4(q, o1); st_bf4(q + 16, o2);
                EPI_ROWS_END
            }
        }
    }
};

struct EpiUq {
    static constexpr bool PERM = false, AFTER_DRAIN = false;
    unsigned char* ws_; float* out_; int layer_;
    __device__ __forceinline__ void operator()(const f32x4 (&acc)[2][2][4][2], const Unit& u, int wr, int wc, int fr, int fq) const {
        const int pn = u.pn; EPI_PTRS
        if (pn < 2) {
            EPI_ROWS_BEGIN
                const f32x4 sa_ = *(const f32x4*)(ssq_q + (size_t)row * 8), sb_ = *(const f32x4*)(ssq_q + (size_t)row * 8 + 4); const float ri = 1.0f / sqrtf((((sa_[0] + sa_[1]) + (sa_[2] + sa_[3])) + ((sb_[0] + sb_[1]) + (sb_[2] + sb_[3]))) * (1.0f / 384.0f) + LN_EPS);
                bf16* rp = P.MIX + (unsigned)(row * DMIX + 512 + pn * 256 + cl);
                EPI_COLS_BEGIN st_bf4(rp + co, v * ri); EPI_COLS_END
            EPI_ROWS_END
        } else {
            EPI_ROWS_BEGIN
                const f32x4 sa_ = *(const f32x4*)(ssq_q + (size_t)row * 8), sb_ = *(const f32x4*)(ssq_q + (size_t)row * 8 + 4); const float ri = 1.0f / sqrtf((((sa_[0] + sa_[1]) + (sa_[2] + sa_[3])) + ((sb_[0] + sb_[1]) + (sb_[2] + sb_[3]))) * (1.0f / 384.0f) + LN_EPS);
                const int b = row / LSEQ, t = row - b * LSEQ;
                const f32x4* tp = (const f32x4*)(P.tab32 + (size_t)t * 16 + 4 * fq); const f32x4 cs0 = tp[0], cs1 = tp[1];
#pragma unroll
                for (int bj = 0; bj < 2; ++bj) { const int head = 4 * bj + wc; const f32x4 x1 = acc[ai][bj][m][0] * ri, x2 = acc[ai][bj][m][1] * ri; f32x4 o1, o2;
                    o1[0] = x1[0] * cs0[0] - x2[0] * cs0[1]; o2[0] = x1[0] * cs0[1] + x2[0] * cs0[0];
                    o1[1] = x1[1] * cs0[2] - x2[1] * cs0[3]; o2[1] = x1[1] * cs0[3] + x2[1] * cs0[2];
                    o1[2] = x1[2] * cs1[0] - x2[2] * cs1[1]; o2[2] = x1[2] * cs1[1] + x2[2] * cs1[0];
                    o1[3] = x1[3] * cs1[2] - x2[3] * cs1[3]; o2[3] = x1[3] * cs1[3] + x2[3] * cs1[2];
                    bf16* q = P.QR + (size_t)row * 256 + 32 * head + 4 * fq; st_bf4(q, o1); st_bf4(q + 16, o2); }
            EPI_ROWS_END
        }
    }
};

struct EpiUkv {
    static constexpr bool PERM = false, AFTER_DRAIN = false;
    unsigned char* ws_; float* out_; int layer_;
    __device__ __forceinline__ void operator()(const f32x4 (&acc)[2][2][4][2], const Unit& u, int wr, int wc, int fr, int fq) const {
        const int pn = u.pn; EPI_PTRS
        if (pn < 2) {
            EPI_ROWS_BEGIN
                const f32x4 sa_ = *(const f32x4*)(ssq_kv + (size_t)row * 4); const float ri = 1.0f / sqrtf(((sa_[0] + sa_[1]) + (sa_[2] + sa_[3])) * (1.0f / 256.0f) + LN_EPS);
                bf16* rp = P.KN + (unsigned)(row * 512 + pn * 256 + cl);
                EPI_COLS_BEGIN st_bf4(rp + co, v * ri); EPI_COLS_END
            EPI_ROWS_END
        } else {
            EPI_ROWS_BEGIN
                const f32x4 sa_ = *(const f32x4*)(ssq_kv + (size_t)row * 4); const float ri = 1.0f / sqrtf(((sa_[0] + sa_[1]) + (sa_[2] + sa_[3])) * (1.0f / 256.0f) + LN_EPS);
                const int b = row / LSEQ, t = row - b * LSEQ;
                EPI_COLS_BEGIN
                    const int cc = (pn - 2) * 256 + c, head = cc >> 6, d = cc & 63;
                    bf16* q = P.VTMLA + ((size_t)(b * 8 + head) * 64 + d) * LSEQ + t;
                    q[0] = (bf16)f2bf(v[0] * ri); q[LSEQ] = (bf16)f2bf(v[1] * ri); q[2 * LSEQ] = (bf16)f2bf(v[2] * ri); q[3 * LSEQ] = (bf16)f2bf(v[3] * ri);
                EPI_COLS_END
            EPI_ROWS_END
        }
    }
};

struct EpiRes {
    static constexpr bool PERM = true, AFTER_DRAIN = false;
    float* H;
    __device__ __forceinline__ void operator()(const f32x4 (&acc)[2][2][4][2], const Unit& u, int wr, int wc, int fr, int fq) const {
        EPI_ROWS_BEGIN
            float* rp = H + (unsigned)(row * DM + u.pn * 256 + wc * 32 + fq * 8);
#pragma unroll
            for (int bj = 0; bj < 2; ++bj) { f32x4* q = (f32x4*)(rp + bj * 128); const f32x4 h0 = q[0], h1 = q[1];
                q[0] = h0 * DN_ALPHA + acc[ai][bj][m][0]; q[1] = h1 * DN_ALPHA + acc[ai][bj][m][1]; }
        EPI_ROWS_END
    }
};

struct EpiResT {
    static constexpr bool PERM = true, AFTER_DRAIN = false;
    bf16* T;
    __device__ __forceinline__ void operator()(const f32x4 (&acc)[2][2][4][2], const Unit& u, int wr, int wc, int fr, int fq) const {
        EPI_ROWS_BEGIN
            bf16* rp = T + (unsigned)(row * DM + u.pn * 256 + wc * 32 + fq * 8);
#pragma unroll
            for (int bj = 0; bj < 2; ++bj) { const f32x4 a0 = acc[ai][bj][m][0], a1 = acc[ai][bj][m][1];
                *(u32x4*)(rp + bj * 128) = (u32x4){cvtpk(a0[0], a0[1]), cvtpk(a0[2], a0[3]), cvtpk(a1[0], a1[1]), cvtpk(a1[2], a1[3])}; }
        EPI_ROWS_END
    }
};

struct EpiFf1 {
    static constexpr bool PERM = true, AFTER_DRAIN = false;
    bf16* U;
    __device__ __forceinline__ void operator()(const f32x4 (&acc)[2][2][4][2], const Unit& u, int wr, int wc, int fr, int fq) const {
        EPI_ROWS_BEGIN
            bf16* rp = U + (unsigned)(row * DFF + u.pn * 256 + wc * 32 + fq * 8);
#pragma unroll
            for (int bj = 0; bj < 2; ++bj) { f32x4 a0 = acc[ai][bj][m][0], a1 = acc[ai][bj][m][1];
#pragma unroll
                for (int j = 0; j < 4; ++j) { a0[j] = fmaxf(a0[j], 0.f); a1[j] = fmaxf(a1[j], 0.f); }
                a0 = a0 * a0; a1 = a1 * a1;
                *(u32x4*)(rp + bj * 128) = (u32x4){cvtpk(a0[0], a0[1]), cvtpk(a0[2], a0[3]), cvtpk(a1[0], a1[1]), cvtpk(a1[2], a1[3])}; }
        EPI_ROWS_END
    }
};

constexpr int TAIL_PM0 = 128, TAIL_ROW0 = TAIL_PM0 * 256, NSPLIT = 4;
struct EpiPart {
    static constexpr bool PERM = true, AFTER_DRAIN = false;
    float* PART; int ktper;
    __device__ __forceinline__ void operator()(const f32x4 (&acc)[2][2][4][2], const Unit& u, int wr, int wc, int fr, int fq) const {
        float* slab = PART + (size_t)(u.kt0 / ktper) * (1024 * 1024);
        EPI_ROWS_BEGIN
            float* rp = slab + (unsigned)((row - TAIL_ROW0) * DM + u.pn * 256 + wc * 32 + fq * 8);
#pragma unroll
            for (int bj = 0; bj < 2; ++bj) { f32x4* q = (f32x4*)(rp + bj * 128); q[0] = acc[ai][bj][m][0]; q[1] = acc[ai][bj][m][1]; }
        EPI_ROWS_END
    }
};
struct TailOrder {
    int G, c, ktper;
    __device__ bool next(int i, Unit& u) const { const int Lx = i * G + c; if (Lx >= 16 * NSPLIT) return false; const int tile = Lx / NSPLIT, ks = Lx % NSPLIT;
        u.pm = TAIL_PM0 + (tile >> 2); u.pn = tile & 3; u.kt0 = ks * ktper; return true; }
    __device__ __forceinline__ void a_ready(const Unit&) const {}
    __device__ __forceinline__ void done(const Unit&) const {}
};

namespace att {
constexpr int KBUF = 64 * 208, VBUF = 128 * 144, OFF_K = 0, OFF_V = 2 * KBUF, OFF_WS = OFF_V + 2 * VBUF, OFF_UNIT = OFF_WS + 8 * 256, OFF_ST = OFF_UNIT + 256, STROW = 144;
__device__ __forceinline__ int crow(int r, int hi) { return (r & 3) + 8 * (r >> 2) + 4 * hi; }
#define MFMA32(a, b, c) __builtin_amdgcn_mfma_f32_32x32x16_bf16((a), (b), (c), 0, 0, 0)


__device__ __forceinline__ void pack4(const f32x16& p0, const f32x16& p1, u32x4 (&pf)[4]) {
    pf[0] = (u32x4){cvtpk(p0[0], p0[1]), cvtpk(p0[2], p0[3]), cvtpk(p0[4], p0[5]), cvtpk(p0[6], p0[7])};
    pf[1] = (u32x4){cvtpk(p0[8], p0[9]), cvtpk(p0[10], p0[11]), cvtpk(p0[12], p0[13]), cvtpk(p0[14], p0[15])};
    pf[2] = (u32x4){cvtpk(p1[0], p1[1]), cvtpk(p1[2], p1[3]), cvtpk(p1[4], p1[5]), cvtpk(p1[6], p1[7])};
    pf[3] = (u32x4){cvtpk(p1[8], p1[9]), cvtpk(p1[10], p1[11]), cvtpk(p1[12], p1[13]), cvtpk(p1[14], p1[15])};
}
template <bool MASK>
__device__ __forceinline__ void sb_sub(const f32x16& p, int keybase, int tq, int hi, float& carry, u32x4& f0, u32x4& f1) {
    float kp[16];
#pragma unroll
    for (int r = 0; r < 16; ++r) {
        const float e = ex2(p[r]); float kk = __builtin_amdgcn_rcpf(1.0f + e);
        if (MASK) { const int key = keybase + crow(r, hi); const bool ok = (key < tq) && (key >= NPAD); kk = ok ? kk : 1.0f; }
        kp[r] = kk;
    }
    float G[4], Gp[4], GG[4];
#pragma unroll
    for (int q = 0; q < 4; ++q) { G[q] = (kp[4 * q] * kp[4 * q + 1]) * (kp[4 * q + 2] * kp[4 * q + 3]);
        const auto rr = __builtin_amdgcn_permlane32_swap(__float_as_uint(G[q]), __float_as_uint(G[q]), false, false);
        Gp[q] = __uint_as_float(rr[1]); GG[q] = __uint_as_float(rr[0]) * __uint_as_float(rr[1]); }
    float T[4]; T[3] = 1.0f; T[2] = GG[3]; T[1] = GG[3] * GG[2]; T[0] = T[1] * GG[1];
    float w[16];
#pragma unroll
    for (int q = 0; q < 4; ++q) {
        const float e3 = carry * T[q] * (hi == 0 ? Gp[q] : 1.0f);
        const float e2 = e3 * kp[4 * q + 3], e1 = e2 * kp[4 * q + 2], e0 = e1 * kp[4 * q + 1], em = e0 * kp[4 * q];
        w[4 * q + 3] = e3 - e2; w[4 * q + 2] = e2 - e1; w[4 * q + 1] = e1 - e0; w[4 * q] = e0 - em;
    }
    carry *= T[0] * GG[0];
    f0 = (u32x4){cvtpk(w[0], w[1]), cvtpk(w[2], w[3]), cvtpk(w[4], w[5]), cvtpk(w[6], w[7])};
    f1 = (u32x4){cvtpk(w[8], w[9]), cvtpk(w[10], w[11]), cvtpk(w[12], w[13]), cvtpk(w[14], w[15])};
}
template <int KIND>
__device__ __forceinline__ void unit(const Ptrs& P, int bh, int u, LAS unsigned char* lds, bool do_store) {
    constexpr int DQK = (KIND == 1) ? 96 : 64, DV = (KIND == 2) ? 128 : 64, NH = (KIND == 2) ? 4 : 8, KROW = DQK * 2 + 16, VROW = 144, NQF = DQK / 16, NDB = DV / 32;
    int tid_l = threadIdx.x; asm volatile("" : "+v"(tid_l));
    const int tid = tid_l, lane = tid & 63, r32 = lane & 31, hi = lane >> 5, wid = __builtin_amdgcn_readfirstlane(tid >> 6);
    const int b = bh / NH, h = bh % NH;
    const int q0 = (u == 0) ? 0 : 128 + 256 * (u - 1), nrows = (u == 0) ? 128 : 256, ktmax = (u == 0) ? 1 : 4 * u + 1;
    const size_t rowb = (size_t)b * LSEQ;
    const bool active = (32 * wid < nrows);
    const int q0w = q0 + 32 * wid, tq = q0w + r32, ktw = (q0w + 31) >> 6;
    const bf16* Qb; int ldq; const bf16* Kb; int ldk; const bf16* VT;
    if (KIND == 0) { Qb = P.MIX + h * 64; ldq = DMIX; Kb = P.KSB + h * 64; ldk = 512; VT = P.VTSB; }
    else if (KIND == 1) { Qb = P.MIX + 512 + h * 64; ldq = DMIX; Kb = P.KN + h * 64; ldk = 512; VT = P.VTMLA; }
    else { Qb = P.RQ + h * 64; ldq = 256; Kb = P.RK + h * 64; ldk = 256; VT = P.RVT; }
    VT += (size_t)bh * DV * LSEQ;
    bf16x8 qf[NQF];
#pragma unroll
    for (int d0 = 0; d0 < NQF; ++d0) qf[d0] = (bf16x8){0, 0, 0, 0, 0, 0, 0, 0};
    if (active) {
#pragma unroll
        for (int d0 = 0; d0 < 4; ++d0) qf[d0] = *(const bf16x8*)(Qb + (rowb + tq) * ldq + 16 * d0 + 8 * hi);
        if (KIND == 1) {
#pragma unroll
            for (int d0 = 0; d0 < 2; ++d0) qf[(KIND == 1) ? 4 + d0 : 0] = *(const bf16x8*)(P.QR + (rowb + tq) * 256 + h * 32 + 16 * d0 + 8 * hi);
        }
    }
    f32x16 o[NDB];
#pragma unroll
    for (int d = 0; d < NDB; ++d) o[d] = (f32x16){0.f, 0.f, 0.f, 0.f, 0.f, 0.f, 0.f, 0.f, 0.f, 0.f, 0.f, 0.f, 0.f, 0.f, 0.f, 0.f};
    float carry = 1.0f, mrun = -1e30f, lrun = 0.f;
    LAS float* wsf = (LAS float*)(lds + OFF_WS) + wid * 64;
    u32x4 kreg, kreg2 = (u32x4){0u, 0u, 0u, 0u}, vreg[DV / 64];
    const int srow = tid >> 3, sch = tid & 7;
#define ATT_LOAD(kt_) do { const size_t key0_ = rowb + (size_t)64 * (kt_); \
        kreg = *(const u32x4*)(Kb + (key0_ + srow) * ldk + sch * 8); \
        if (KIND == 1 && tid < 256) kreg2 = *(const u32x4*)(P.KR + (key0_ + (tid >> 2)) * 32 + (tid & 3) * 8); \
        _Pragma("unroll") for (int i_ = 0; i_ < DV / 64; ++i_) vreg[i_] = *(const u32x4*)(VT + (size_t)(srow + 64 * i_) * LSEQ + 64 * (kt_) + sch * 8); } while (0)
#define ATT_WRITE(buf_) do { LAS unsigned char* kb_ = lds + OFF_K + (buf_) * KBUF; LAS unsigned char* vb_ = lds + OFF_V + (buf_) * VBUF; \
        *(LAS u32x4*)(kb_ + srow * KROW + sch * 16) = kreg; \
        if (KIND == 1 && tid < 256) *(LAS u32x4*)(kb_ + (tid >> 2) * KROW + 128 + (tid & 3) * 16) = kreg2; \
        _Pragma("unroll") for (int i_ = 0; i_ < DV / 64; ++i_) { LAS unsigned char* q_ = vb_ + (srow + 64 * i_) * VROW + (sch >> 1) * 32 + (sch & 1) * 8; \
            *(LAS u32x2*)q_ = (u32x2){vreg[i_].x, vreg[i_].y}; *(LAS u32x2*)(q_ + 16) = (u32x2){vreg[i_].z, vreg[i_].w}; } } while (0)

    int ktmin = 1;
    if (KIND == 2 && u >= 1) {
        ktmin = q0 >> 6;
        const float g256 = ex2(256.0f * ret_lg(h));
        const int e_ = tid >> 2, dseg = (tid & 3) * 16;
        const float* dp = P.DT + ((size_t)bh * 16 * 128 + e_) * 64 + dseg;
        f32x4 sacc[4];
#pragma unroll
        for (int c_ = 0; c_ < 4; ++c_) sacc[c_] = (f32x4){0.f, 0.f, 0.f, 0.f};
        int blk = 0;
        for (; blk + 4 <= u; blk += 4) {
            f32x4 ld_[4][4];
#pragma unroll
            for (int i_ = 0; i_ < 4; ++i_)
#pragma unroll
                for (int c_ = 0; c_ < 4; ++c_) ld_[i_][c_] = *(const f32x4*)(dp + (size_t)(blk + i_) * 128 * 64 + 4 * c_);
#pragma unroll
            for (int i_ = 0; i_ < 4; ++i_)
#pragma unroll
                for (int c_ = 0; c_ < 4; ++c_) sacc[c_] = sacc[c_] * g256 + ld_[i_][c_];
        }
        for (; blk < u; ++blk) {
#pragma unroll
            for (int c_ = 0; c_ < 4; ++c_) sacc[c_] = sacc[c_] * g256 + *(const f32x4*)(dp + (size_t)blk * 128 * 64 + 4 * c_);
        }
        LAS unsigned char* stp = lds + OFF_ST + e_ * STROW + dseg * 2;
        *(LAS u32x4*)stp = (u32x4){cvtpk(sacc[0][0], sacc[0][1]), cvtpk(sacc[0][2], sacc[0][3]), cvtpk(sacc[1][0], sacc[1][1]), cvtpk(sacc[1][2], sacc[1][3])};
        *(LAS u32x4*)(stp + 16) = (u32x4){cvtpk(sacc[2][0], sacc[2][1]), cvtpk(sacc[2][2], sacc[2][3]), cvtpk(sacc[3][0], sacc[3][1]), cvtpk(sacc[3][2], sacc[3][3])};
        __syncthreads();
        if (active) {
#pragma unroll
            for (int s_ = 0; s_ < 4; ++s_)
#pragma unroll
                for (int d = 0; d < NDB; ++d) {
                    const bf16x8 sf = *(const LAS bf16x8*)(lds + OFF_ST + (32 * d + r32) * STROW + (16 * s_ + 8 * hi) * 2);
                    o[d] = MFMA32(qf[s_], sf, o[d]);
                }
            const float gw_ = ex2((float)(32 * wid) * ret_lg(h));
#pragma unroll
            for (int d = 0; d < NDB; ++d)
#pragma unroll
                for (int r = 0; r < 16; ++r) o[d][r] *= gw_;
        }
    }
    int buf = 0;
    ATT_LOAD(ktmax); ATT_WRITE(0);
    __syncthreads();
    for (int kt = ktmax; kt >= ktmin; --kt) {
        if (kt > ktmin) ATT_LOAD(kt - 1);
        if (active && kt <= ktw) {
            const LAS unsigned char* Kt = lds + OFF_K + buf * KBUF; const LAS unsigned char* Vt = lds + OFF_V + buf * VBUF;
            f32x16 p0 = (f32x16){0.f, 0.f, 0.f, 0.f, 0.f, 0.f, 0.f, 0.f, 0.f, 0.f, 0.f, 0.f, 0.f, 0.f, 0.f, 0.f}, p1 = p0;
            {
                bf16x8 kfa[NQF], kfb[NQF];
#pragma unroll
                for (int d0 = 0; d0 < NQF; ++d0) { kfa[d0] = *(const LAS bf16x8*)(Kt + r32 * KROW + (16 * d0 + 8 * hi) * 2); kfb[d0] = *(const LAS bf16x8*)(Kt + (32 + r32) * KROW + (16 * d0 + 8 * hi) * 2); }
#pragma unroll
                for (int d0 = 0; d0 < NQF; ++d0) { p0 = MFMA32(kfa[d0], qf[d0], p0); p1 = MFMA32(kfb[d0], qf[d0], p1); }
            }
            bf16x8 vfr[(NDB == 2) ? 8 : 1];
            if (NDB == 2) {
#pragma unroll
                for (int ks = 0; ks < 4; ++ks)
#pragma unroll
                    for (int d = 0; d < 2; ++d) vfr[(NDB == 2) ? 2 * ks + d : 0] = *(const LAS bf16x8*)(Vt + (32 * d + r32) * VROW + (16 * ks + 8 * hi) * 2);
            }
            const int k0key = 64 * kt;
            const bool needmask = (k0key + 63 >= q0w) || (kt == 1);
            u32x4 pf[4];
            if (KIND == 0) {
                if (needmask) { sb_sub<true>(p1, k0key + 32, tq, hi, carry, pf[2], pf[3]); sb_sub<true>(p0, k0key, tq, hi, carry, pf[0], pf[1]); }
                else { sb_sub<false>(p1, k0key + 32, tq, hi, carry, pf[2], pf[3]); sb_sub<false>(p0, k0key, tq, hi, carry, pf[0], pf[1]); }
            } else if (KIND == 1) {
                if (needmask) {
#pragma unroll
                    for (int r = 0; r < 16; ++r) { const int key = k0key + crow(r, hi);
                        if (!((key <= tq) && (key >= NPAD))) p0[r] = -1e30f;
                        if (!((key + 32 <= tq) && (key + 32 >= NPAD))) p1[r] = -1e30f; }
                    asm volatile("" : "+v"(p0), "+v"(p1));
                }
                float mx = fmaxf(p0[0], p1[0]);
#pragma unroll
                for (int r = 1; r < 16; ++r) mx = fmaxf(mx, fmaxf(p0[r], p1[r]));
                { const auto rr = __builtin_amdgcn_permlane32_swap(__float_as_uint(mx), __float_as_uint(mx), false, false); mx = fmaxf(__uint_as_float(rr[0]), __uint_as_float(rr[1])); }
                const float mnew = fmaxf(mrun, mx);
                if (__any(mnew > mrun)) {
                    const float alpha = ex2(mrun - mnew); lrun *= alpha;
                    if (hi == 0) wsf[r32] = alpha;
                    asm volatile("s_waitcnt lgkmcnt(0)" ::: "memory");
#pragma unroll
                    for (int r = 0; r < 16; ++r) { const float a = wsf[crow(r, hi)];
#pragma unroll
                        for (int d = 0; d < NDB; ++d) o[d][r] *= a; }
                    asm volatile("s_waitcnt lgkmcnt(0)" ::: "memory");
                }
                mrun = mnew;
                float ls = 0.f;
#pragma unroll
                for (int r = 0; r < 16; ++r) { p0[r] = ex2(p0[r] - mrun); p1[r] = ex2(p1[r] - mrun); ls += p0[r] + p1[r]; }
                lrun += ls;
                pack4(p0, p1, pf);
            } else {
                const float cdec = ex2((float)(q0w - k0key) * ret_lg(h));
#pragma unroll
                for (int r = 0; r < 16; ++r) { p0[r] *= cdec; p1[r] *= cdec; }
                if (needmask) {
#pragma unroll
                    for (int r = 0; r < 16; ++r) { const int key = k0key + crow(r, hi); if (key > tq) p0[r] = 0.f; if (key + 32 > tq) p1[r] = 0.f; }
                    asm volatile("" : "+v"(p0), "+v"(p1));
                }
                pack4(p0, p1, pf);
            }
#pragma unroll
            for (int ks = 0; ks < 4; ++ks) {
                const bf16x8 pa = __builtin_bit_cast(bf16x8, pf[ks]);
#pragma unroll
                for (int d = 0; d < NDB; ++d) {
                    const bf16x8 vf = (NDB == 2) ? vfr[(NDB == 2) ? 2 * ks + d : 0] : *(const LAS bf16x8*)(Vt + (32 * d + r32) * VROW + (16 * ks + 8 * hi) * 2);
                    o[d] = MFMA32(pa, vf, o[d]);
                }
            }
        }
        if (kt > ktmin) ATT_WRITE(buf ^ 1);
        __syncthreads();
        buf ^= 1;
    }
#undef ATT_LOAD
#undef ATT_WRITE
    if (active && do_store) {
        if (KIND == 0) {
#pragma unroll
            for (int r = 0; r < 16; ++r) { bf16* q = P.MIX + (rowb + q0w + crow(r, hi)) * DMIX + h * 64 + r32;
#pragma unroll
                for (int d = 0; d < NDB; ++d) q[32 * d] = (bf16)f2bf(o[d][r]); }
        } else if (KIND == 1) {
            const float lt = lrun + __shfl_xor(lrun, 32);
            if (hi == 0) wsf[r32] = lt;
            asm volatile("s_waitcnt lgkmcnt(0)" ::: "memory");
#pragma unroll
            for (int r = 0; r < 16; ++r) { const float l_ = wsf[crow(r, hi)]; const float inv = l_ > 0.f ? 1.0f / l_ : 0.f;
                bf16* q = P.MIX + (rowb + q0w + crow(r, hi)) * DMIX + 512 + h * 64 + r32;
#pragma unroll
                for (int d = 0; d < NDB; ++d) q[32 * d] = (bf16)f2bf(o[d][r] * inv); }
            asm volatile("s_waitcnt lgkmcnt(0)" ::: "memory");
        } else {
#pragma unroll
            for (int r = 0; r < 16; ++r) {
                float s = 0.f;
#pragma unroll
                for (int d = 0; d < NDB; ++d) s += o[d][r];
#pragma unroll
                for (int x = 1; x < 32; x <<= 1) s += __shfl_xor(s, x);
                const float mean = s * (1.0f / 128.0f); float q2 = 0.f;
#pragma unroll
                for (int d = 0; d < NDB; ++d) { const float dd = o[d][r] - mean; q2 += dd * dd; }
#pragma unroll
                for (int x = 1; x < 32; x <<= 1) q2 += __shfl_xor(q2, x);
                const float rstd = 1.0f / sqrtf(q2 * (1.0f / 128.0f) + LN_EPS);
                bf16* q = P.MIX + (rowb + q0w + crow(r, hi)) * DMIX + 1024 + h * 128 + r32;
#pragma unroll
                for (int d = 0; d < NDB; ++d) { const float g = bf2f(q[32 * d]); const float sl = g / (1.0f + ex2(-g * 1.4426950408889634f));
                    q[32 * d] = (bf16)f2bf(sl * (o[d][r] - mean) * rstd); }
            }
        }
    }
}
__device__ __forceinline__ void ret_state_jobs(const Ptrs& P) {
    int tid_l = threadIdx.x; asm volatile("" : "+v"(tid_l));
    const int lane = tid_l & 63, r32 = lane & 31, hi = lane >> 5, wid = __builtin_amdgcn_readfirstlane(tid_l >> 6), eb = wid >> 1, db = wid & 1;
    for (int job = blockIdx.x; job < 32 * 16; job += gridDim.x) {
        const int bh = job >> 4, blk = job & 15, h = bh & 3;
        const int key0 = blk == 0 ? 0 : 128 + 256 * (blk - 1), ntile = blk == 0 ? 2 : 4;
        const float g64 = ex2(64.0f * ret_lg(h));
        const bf16* va = P.RVT + ((size_t)bh * 128 + 32 * eb + r32) * LSEQ + key0 + 8 * hi;
        const bf16* kb = P.RKT + ((size_t)bh * 64 + 32 * db + r32) * LSEQ + key0 + 8 * hi;
        f32x16 acc = (f32x16){0.f, 0.f, 0.f, 0.f, 0.f, 0.f, 0.f, 0.f, 0.f, 0.f, 0.f, 0.f, 0.f, 0.f, 0.f, 0.f};
        for (int j = 0; j < ntile; ++j) {
            bf16x8 af[4], bfr[4];
#pragma unroll
            for (int s_ = 0; s_ < 4; ++s_) { af[s_] = *(const bf16x8*)(va + 64 * j + 16 * s_); bfr[s_] = *(const bf16x8*)(kb + 64 * j + 16 * s_); }
#pragma unroll
            for (int s_ = 0; s_ < 4; ++s_) acc = MFMA32(af[s_], bfr[s_], acc);
#pragma unroll
            for (int r = 0; r < 16; ++r) acc[r] *= g64;
        }
        float* dst = P.DT + ((size_t)job * 128 + 32 * eb) * 64 + 32 * db + r32;
#pragma unroll
        for (int r = 0; r < 16; ++r) dst[crow(r, hi) * 64] = acc[r];
    }
}
constexpr int UNITS_PER_LEVEL = 64 + 64 + 32, NUNITS = 17 * UNITS_PER_LEVEL;
__device__ __forceinline__ void phase(const Ptrs& P, LAS unsigned char* lds, unsigned* counter, bool do_store) {
    volatile LAS int* ubox = (volatile LAS int*)(lds + OFF_UNIT);
    for (;;) {
        if (threadIdx.x == 0) ubox[0] = (int)atomicAdd(counter, 1u);
        __syncthreads();
        const int i = __builtin_amdgcn_readfirstlane(ubox[0]);
        __syncthreads();
        if (i >= NUNITS) break;
        const int lvl = i / UNITS_PER_LEVEL, j = i % UNITS_PER_LEVEL, u = 16 - lvl;
        if (j < 64) unit<1>(P, j, u, lds, do_store);
        else if (j < 128) unit<0>(P, j - 64, u, lds, do_store);
        else unit<2>(P, j - 128, u, lds, do_store);
    }
}
}

template <int MODE>
__device__ __forceinline__ void colmap(int p, int& src, float& sc) {
    sc = 1.f; src = p;
    if (MODE == 1) {
        if (p < 1536) { if (p < 512) sc = 0.18033688011112042f; }
        else if (p < 2048) { const int c = (p - 1536) & 255, isk = (p >= 1792), bj = c >> 7, wc = (c >> 5) & 3, n = (c >> 4) & 1, i = c & 15;
            src = (isk ? 2464 : 2208) + 64 * (2 * bj + (wc >> 1)) + 32 * n + 16 * (wc & 1) + i; if (isk) sc = 0.125f; }
        else if (p < 2560) src = 2720 + (p - 2048);
        else if (p < 3072) src = 3232 + (p - 2560);
        else if (p < 3328) src = 1920 + (p - 3072);
        else if (p < 3712) src = 1536 + (p - 3328);
        else if (p < 3744) src = 2176 + (p - 3712);
        else src = -1;
    } else if (MODE == 2) {
        sc = 0.14724444602590306f;
        if (p < 512) src = (p >> 6) * 96 + (p & 63); else { const int q = p - 512; src = (q >> 5) * 96 + 64 + (q & 31); }
    } else if (MODE == 3) {
        if (p < 512) src = (p >> 6) * 128 + (p & 63); else { const int q = p - 512; src = (q >> 6) * 128 + 64 + (q & 63); }
    }
}
template <int MODE>
__device__ __forceinline__ void conv_item(const float* W, int K, int Nsrc, int Nphys, const float* gain, bf16* WT, LAS float* scr, int item, int lane) {
    const int nblk = Nphys / 32, kb = item / nblk, nb = item % nblk, k0 = 64 * kb, n0 = 32 * nb;
    int src; float sc; colmap<MODE>(n0 + (lane & 31), src, sc);
#pragma unroll 8
    for (int i = 0; i < 32; ++i) { const int kk = 2 * i + (lane >> 5); float v = 0.f;
        if (src >= 0) { v = W[(size_t)(k0 + kk) * Nsrc + src] * sc; if (gain) v *= gain[k0 + kk]; }
        scr[kk * 33 + (lane & 31)] = v; }
    asm volatile("s_waitcnt lgkmcnt(0)" ::: "memory");
    const int c = lane & 7;
#pragma unroll
    for (int j = 0; j < 4; ++j) { const int n = (lane >> 3) + 8 * j; const LAS float* s = scr + (8 * c) * 33 + n;
        u32x4 o; o.x = cvtpk(s[0 * 33], s[1 * 33]); o.y = cvtpk(s[2 * 33], s[3 * 33]); o.z = cvtpk(s[4 * 33], s[5 * 33]); o.w = cvtpk(s[6 * 33], s[7 * 33]);
        *(u32x4*)(WT + (size_t)(n0 + n) * K + k0 + 8 * c) = o; }
    asm volatile("s_waitcnt lgkmcnt(0)" ::: "memory");
}
__device__ __forceinline__ void convert_weights(const Ptrs& P, int layer, LAS unsigned char* lds, int gw, int NGW, int wave, int lane) {
    LAS float* scr = (LAS float*)(lds + wave * 16384);
    constexpr int I_IN = 16 * (NIN / 32), I_UQ = 6 * 24, I_UKV = 4 * 32, I_OUT = 24 * 32, I_1 = 16 * 128, I_2 = 64 * 32, NIT = I_IN + I_UQ + I_UKV + I_OUT + I_1 + I_2;
    const float* w_in = P.in[4] + (size_t)layer * 1024 * NIN_LOG; const float* gq = P.in[5] + layer * 384; const float* gkv = P.in[6] + layer * 256;
    const float* w_uq = P.in[7] + (size_t)layer * 384 * 768; const float* w_ukv = P.in[8] + (size_t)layer * 256 * 1024; const float* w_out = P.in[9] + (size_t)layer * 1536 * 1024;
    const float* w1 = P.in[12] + (size_t)layer * 1024 * 4096; const float* w2 = P.in[13] + (size_t)layer * 4096 * 1024;
    for (int it = gw; it < NIT; it += NGW) {
        int r = it;
        if (r < I_IN) { conv_item<1>(w_in, 1024, NIN_LOG, NIN, nullptr, P.Win, scr, r, lane); continue; } r -= I_IN;
        if (r < I_UQ) { conv_item<2>(w_uq, 384, 768, 768, gq, P.Wuq, scr, r, lane); continue; } r -= I_UQ;
        if (r < I_UKV) { conv_item<3>(w_ukv, 256, 1024, 1024, gkv, P.Wukv, scr, r, lane); continue; } r -= I_UKV;
        if (r < I_OUT) { conv_item<0>(w_out, 1536, 1024, 1024, nullptr, P.Wout, scr, r, lane); continue; } r -= I_OUT;
        if (r < I_1) { conv_item<0>(w1, 1024, 4096, 4096, nullptr, P.W1, scr, r, lane); continue; } r -= I_1;
        conv_item<0>(w2, 4096, 1024, 1024, nullptr, P.W2, scr, r, lane);
    }
}
__device__ __forceinline__ void ln_regs(f32x4 (&v)[4], const float* g, const float* bta, int lane) {
    float s = 0.f;
#pragma unroll
    for (int j = 0; j < 4; ++j) s += (v[j][0] + v[j][1]) + (v[j][2] + v[j][3]);
    const float mean = wave_sum(s) * (1.f / DM); float s2 = 0.f;
#pragma unroll
    for (int j = 0; j < 4; ++j) { v[j] = v[j] - mean; s2 += (v[j][0] * v[j][0] + v[j][1] * v[j][1]) + (v[j][2] * v[j][2] + v[j][3] * v[j][3]); }
    const float rstd = 1.f / sqrtf(wave_sum(s2) * (1.f / DM) + LN_EPS);
#pragma unroll
    for (int j = 0; j < 4; ++j) { const f32x4 gg = ((const f32x4*)g)[64 * j + lane], bb = ((const f32x4*)bta)[64 * j + lane]; v[j] = v[j] * rstd * gg + bb; }
}
__device__ __forceinline__ void store_h_hb(const Ptrs& P, int row, const f32x4 (&v)[4], int lane, bool write_h) {
#pragma unroll
    for (int j = 0; j < 4; ++j) {
        if (write_h) ((f32x4*)(P.H + (size_t)row * DM))[64 * j + lane] = v[j];
        u32x2 w; w.x = cvtpk(v[j][0], v[j][1]); w.y = cvtpk(v[j][2], v[j][3]); ((u32x2*)(P.HB + (size_t)row * DM))[64 * j + lane] = w; }
}
__device__ __forceinline__ void phase_prep(const Ptrs& P, LAS unsigned char* lds, int gw, int NGW, int wave, int lane) {
    convert_weights(P, 0, lds, gw, NGW, wave, lane);
    const int gt = gw * 64 + lane, NGT = NGW * 64;
    for (int i = gt; i < LSEQ * 48; i += NGT) {
        const int t = i / 48, k = i % 48; const float pos = (float)(t - NPAD);
        const float inv = (k < 32) ? ex2(-(float)k * (13.287712379549449f / 32.0f)) : ex2(-(float)(k - 32) * (13.287712379549449f / 16.0f));
        const float ang = pos * inv;
        double rev = (double)ang * 0.15915494309189535; rev -= floor(rev); const float fr = (float)rev;
        const f32x2 cs = {__builtin_amdgcn_cosf(fr), __builtin_amdgcn_sinf(fr)};
        if (k < 32) P.tab64[(size_t)t * 32 + k] = cs; else P.tab32[(size_t)t * 16 + (k - 32)] = cs;
    }
    const float* x = P.in[0]; const float* meta = P.in[1]; const float* g = P.in[2]; const float* bta = P.in[3];
    for (int row = gw; row < MROWS; row += NGW) {
        const int b = row / LSEQ, t = row - b * LSEQ; f32x4 v[4];
#pragma unroll
        for (int j = 0; j < 4; ++j) {
            if (t < NPAD) v[j] = (f32x4){0.f, 0.f, 0.f, 0.f};
            else if (t < 128) v[j] = ((const f32x4*)(meta + (size_t)(t - NPAD) * DM))[64 * j + lane];
            else v[j] = ((const f32x4*)(x + ((size_t)b * SEQ + (t - 128)) * DM))[64 * j + lane]; }
        ln_regs(v, g, bta, lane);
        store_h_hb(P, row, v, lane, false);
    }
}
__device__ __forceinline__ void ln_store(const Ptrs& P, int row, const f32x4 (&v)[4], int lane, bool final_out) {
    if (!final_out) store_h_hb(P, row, v, lane, false);
    else { const int b = row / LSEQ, t = row - b * LSEQ;
        if (t >= 128) {
#pragma unroll
            for (int j = 0; j < 4; ++j) ((f32x4*)(P.out + ((size_t)b * SEQ + (t - 128)) * DM))[64 * j + lane] = v[j]; } }
}
__device__ __forceinline__ f32x4 unpk_bf4(u32x2 t) { return (f32x4){__builtin_bit_cast(float, t.x << 16), __builtin_bit_cast(float, t.x & 0xffff0000u), __builtin_bit_cast(float, t.y << 16), __builtin_bit_cast(float, t.y & 0xffff0000u)}; }
__device__ __forceinline__ void phase_ln(const Ptrs& P, const bf16* T, const float* g, const float* bta, bool final_out, int gw, int NGW, int lane) {
    int row = gw;
    for (; row + NGW < TAIL_ROW0; row += 2 * NGW) {
        f32x4 va[4], vb[4];
#pragma unroll
        for (int j = 0; j < 4; ++j) {
            const u32x2 h0 = ((const u32x2*)(P.HB + (size_t)row * DM))[64 * j + lane], h1 = ((const u32x2*)(P.HB + (size_t)(row + NGW) * DM))[64 * j + lane];
            const u32x2 t0 = ((const u32x2*)(T + (size_t)row * DM))[64 * j + lane], t1 = ((const u32x2*)(T + (size_t)(row + NGW) * DM))[64 * j + lane];
            va[j] = unpk_bf4(h0) * DN_ALPHA + unpk_bf4(t0); vb[j] = unpk_bf4(h1) * DN_ALPHA + unpk_bf4(t1); }
        ln_regs(va, g, bta, lane); ln_regs(vb, g, bta, lane);
        ln_store(P, row, va, lane, final_out); ln_store(P, row + NGW, vb, lane, final_out);
    }
    for (; row < MROWS; row += NGW) {
        f32x4 v[4];
#pragma unroll
        for (int j = 0; j < 4; ++j) v[j] = unpk_bf4(((const u32x2*)(P.HB + (size_t)row * DM))[64 * j + lane]);
        if (row >= TAIL_ROW0) {
            const float* part = (const float*)(P.ws + WS_PART) + (size_t)(row - TAIL_ROW0) * DM;
#pragma unroll
            for (int j = 0; j < 4; ++j) { f32x4 sacc = ((const f32x4*)part)[64 * j + lane];
#pragma unroll
                for (int ks = 1; ks < NSPLIT; ++ks) sacc += ((const f32x4*)(part + (size_t)ks * 1024 * 1024))[64 * j + lane];
                v[j] = v[j] * DN_ALPHA + sacc; }
        } else {
#pragma unroll
            for (int j = 0; j < 4; ++j) v[j] = v[j] * DN_ALPHA + unpk_bf4(((const u32x2*)(T + (size_t)row * DM))[64 * j + lane]);
        }
        ln_regs(v, g, bta, lane);
        ln_store(P, row, v, lane, final_out);
    }
}

#define XB_TMO      128
#define XB_XCNT(j)  (256  + 64 * (j))
#define XB_XSUB(j)  (1280 + 64 * (j))
#define XB_XGEN(j)  (2304 + 64 * (j))
#define XB_TOP      3328
#define XB_TOPGEN   3392
#define XCD_BAR_WORDS 3456
#define XB_SPIN_CAP (1u << 18)

__device__ __forceinline__ unsigned xb_ld(unsigned* p)              { return __hip_atomic_load(p, __ATOMIC_RELAXED, __HIP_MEMORY_SCOPE_AGENT); }
__device__ __forceinline__ unsigned xb_add(unsigned* p, unsigned v) { return __hip_atomic_fetch_add(p, v, __ATOMIC_RELAXED, __HIP_MEMORY_SCOPE_AGENT); }
__device__ __forceinline__ unsigned xb_xcc_id() { return (unsigned)__builtin_amdgcn_s_getreg((3 << 11) | 20) & 0xFu; }
#define XB_SPIN(cond, bar) do { unsigned _sp = 0; while (cond) { __builtin_amdgcn_s_sleep(1); \
    if ((++_sp & 255u) == 0u) { if (xb_ld(&(bar)[XB_TMO])) break; if (_sp > XB_SPIN_CAP) { atomicAdd(&(bar)[XB_TMO], 1u); break; } } } } while (0)

struct XcdBarrier {
    unsigned* bar; unsigned x;
    volatile LAS unsigned* st;
};

__device__ __forceinline__ XcdBarrier xcd_barrier_post(unsigned* bar, volatile LAS unsigned* st) {
    XcdBarrier b; b.bar = bar; b.x = xb_xcc_id(); b.st = st;
    if (threadIdx.x == 0) (void)xb_add(&bar[XB_XCNT(b.x)], 1u);
    return b;
}
__device__ __forceinline__ void xcd_barrier_complete(unsigned* bar, unsigned x, unsigned& nloc, unsigned& nx) {
    const unsigned G = gridDim.x * gridDim.y * gridDim.z;
    unsigned sum, cnt, mine, sp = 0u;
    for (;;) {
        sum = 0u; cnt = 0u; mine = 0u;
#pragma unroll
        for (unsigned j = 0; j < 16; ++j) { const unsigned c = xb_ld(&bar[XB_XCNT(j)]); sum += c; cnt += (c > 0u) ? 1u : 0u; mine = (j == x) ? c : mine; }
        if (sum == G) break;
        __builtin_amdgcn_s_sleep(1);
        if ((++sp & 255u) == 0u) { if (xb_ld(&bar[XB_TMO])) break; if (sp > XB_SPIN_CAP) { atomicAdd(&bar[XB_TMO], 1u); break; } }
    }
    nloc = mine > 0u ? mine : 1u; nx = cnt > 0u ? cnt : 1u;
}

__device__ __forceinline__ void xcd_barrier(const XcdBarrier& b) {
    asm volatile("s_waitcnt vmcnt(0)" ::: "memory");
    __syncthreads();
    if (threadIdx.x == 0) {
        unsigned* bar = b.bar;
        __builtin_amdgcn_s_waitcnt(0);
        unsigned nloc = b.st[0], nx = b.st[1];
        if (nloc == 0u) { xcd_barrier_complete(bar, b.x, nloc, nx); b.st[0] = nloc; b.st[1] = nx; }
        const unsigned old = xb_add(&bar[XB_XSUB(b.x)], 1u);
        const unsigned gen = old / nloc;
        if (old + 1u == (gen + 1u) * nloc) {
            __builtin_amdgcn_fence(__ATOMIC_RELEASE, "agent");
            asm volatile("s_waitcnt vmcnt(0)" ::: "memory");
            const unsigned og = xb_add(&bar[XB_TOP], 1u);
            const unsigned tg = og / nx;
            if (og + 1u == (tg + 1u) * nx) xb_add(&bar[XB_TOPGEN], 1u);
            else XB_SPIN(xb_ld(&bar[XB_TOPGEN]) == tg, bar);
            __builtin_amdgcn_fence(__ATOMIC_ACQUIRE, "agent");
            xb_add(&bar[XB_XGEN(b.x)], 1u);
            asm volatile("s_waitcnt vmcnt(0)" ::: "memory");
        } else {
            XB_SPIN(xb_ld(&bar[XB_XGEN(b.x)]) == gen, bar);
            __builtin_amdgcn_fence(__ATOMIC_ACQUIRE, "agent");
            asm volatile("s_waitcnt vmcnt(0)" ::: "memory");
        }
    }
    __syncthreads();
}

struct Args { const float* in[16]; float* out; unsigned char* ws; int ph_lo, ph_hi; };
static_assert(sizeof(Args) == 16 * 8 + 8 + 8 + 8, "Args has no padding");

template <class Epi>
__device__ __forceinline__ void run_gemm(LAS unsigned char* lds, const bf16* A, const bf16* Bt, int N, int K, const Epi& E, int rot = 0) {
    pg8::Gemm g{A, Bt, MROWS, N, K, K}; pg8::StaticOrder S; S.init(MROWS, N, (int)gridDim.x, ((int)blockIdx.x + rot) % (int)gridDim.x);
    pg8::gemm_phase<Epi, pg8::StaticOrder, true, true>(lds, g, S, E);
}
__device__ __forceinline__ void run_gemm_res(LAS unsigned char* lds, const bf16* A, const bf16* Bt, int K, float* H, float* PART, bf16* T) {
    const int rot = ((int)blockIdx.x + 128) % (int)gridDim.x;
    { EpiPart E{PART, K / 64 / NSPLIT}; pg8::Gemm g{A, Bt, MROWS, 1024, K / NSPLIT, K}; TailOrder S{(int)gridDim.x, rot, K / 64 / NSPLIT};
      pg8::gemm_phase<EpiPart, TailOrder, true, true>(lds, g, S, E); }
    { EpiResT E{T}; pg8::Gemm g{A, Bt, TAIL_ROW0, 1024, K, K}; pg8::StaticOrder S; S.init(TAIL_ROW0, 1024, (int)gridDim.x, (int)blockIdx.x);
      pg8::gemm_phase<EpiResT, pg8::StaticOrder, true, true>(lds, g, S, E); }
    (void)H;
}

__global__ void __launch_bounds__(NTHREADS, 2) mk_fwd(Args a) {
    extern __shared__ __attribute__((aligned(16))) unsigned char lds_raw[];
    LAS unsigned char* lds = (LAS unsigned char*)lds_raw;
    volatile LAS unsigned* MISC = (volatile LAS unsigned*)(lds + 143360);
    if (threadIdx.x < 32) MISC[threadIdx.x] = 0u;
    __syncthreads();
    XcdBarrier xbar = xcd_barrier_post((unsigned*)(a.ws + WS_MISC + MISC_CTL) + 4096, MISC + 8);
    for (int ph = a.ph_lo; ph < a.ph_hi; ++ph) {
        int tid_l = threadIdx.x; asm volatile("" : "+v"(tid_l));
        const int tid = tid_l, lane = tid & 63, wave = __builtin_amdgcn_readfirstlane(tid >> 6);
        const int gw = (int)blockIdx.x * NWAVES + wave, NGW = (int)gridDim.x * NWAVES;
    size_t zoff = 0; asm volatile("" : "+s"(zoff));
    Ptrs P;
#pragma unroll
    for (int i = 0; i < 16; ++i) P.in[i] = a.in[i] + zoff;
    unsigned char* wsl = a.ws + zoff; float* outl = a.out + zoff;
    fill_ptrs(P, wsl, outl);
        if (ph == 0) phase_prep(P, lds, gw, NGW, wave, lane);
        else {
            const int l = (ph - 1) >> 3, s = (ph - 1) & 7;
            if (s == 0) {
#ifndef NO_IN
 EpiIn E{wsl, outl, l}; run_gemm(lds, P.HB, P.Win, NIN, 1024, E);
#endif
 }
            else if (s == 1) {
#ifndef NO_U
 { EpiUq E{wsl, outl, l}; run_gemm(lds, P.CQ, P.Wuq, 768, 384, E); } { EpiUkv E{wsl, outl, l}; run_gemm(lds, P.CKV, P.Wukv, 1024, 256, E, 104); }
 att::ret_state_jobs(P);
#endif
 }
            else if (s == 2) {
#ifndef NO_ATT
#ifdef PROBE_ATT
 const int nrep = 2 + (int)P.ctl[1];
#else
 const int nrep = 1;
#endif
 for (int rep = 0; rep < nrep; ++rep) att::phase(P, lds, P.ctl + 64 * (l + 1 + 8 * rep), rep == nrep - 1);
#endif
 }
            else if (s == 3) {
#ifndef NO_RES
 run_gemm_res(lds, P.MIX, P.Wout, 1536, P.H, (float*)(wsl + WS_PART), (bf16*)P.H);
#endif
 }
            else if (s == 4) phase_ln(P, (bf16*)P.H, P.in[10] + l * DM, P.in[11] + l * DM, false, gw, NGW, lane);
            else if (s == 5) {
#ifndef NO_FF
 EpiFf1 E{P.U};
#ifdef PROBE_FF1
 const int nrep1 = 2 + (int)P.ctl[1];
#else
 const int nrep1 = 1;
#endif
 for (int rep = 0; rep < nrep1; ++rep) run_gemm(lds, P.HB, P.W1, 4096, 1024, E);
#endif
 }
            else if (s == 6) {
#ifndef NO_RES
 run_gemm_res(lds, P.U, P.W2, 4096, P.H, (float*)(wsl + WS_PART), (bf16*)P.H);
#endif
 }
            else { if (l + 1 < DEPTH) convert_weights(P, l + 1, lds, gw, NGW, wave, lane);
                   phase_ln(P, (bf16*)P.H, P.in[14] + l * DM, P.in[15] + l * DM, l + 1 == DEPTH, gw, NGW, lane); }
        }
#ifndef T_NOSYNC
        if (ph + 1 < a.ph_hi) { if (ph == a.ph_lo) cg::this_grid().sync(); else xcd_barrier(xbar); }
#ifdef PROBE_SYNC
        if (ph + 1 < a.ph_hi) { cg::this_grid().sync(); cg::this_grid().sync(); }
#endif
#endif
    }
}

extern "C" void kernel_launch(void* const* d_in, const int* in_sizes, int n_in, void* d_out, int out_size, void* d_ws, size_t ws_size, hipStream_t stream) {
    static int grid = 0;
    if (grid == 0) {
        if (n_in != 16 || in_sizes[0] != BATCH * SEQ * DM || out_size != BATCH * SEQ * DM || ws_size < WS_END) {
            fprintf(stderr, "kernel_launch: unexpected shapes (n_in %d, in0 %d, out %d, ws %zu, need %zu); nothing launched\n", n_in, n_in > 0 ? in_sizes[0] : -1, out_size, ws_size, (size_t)WS_END); grid = -1; return; }
        int dev = 0, cus = 0, per_cu = 0;
        if (hipGetDevice(&dev) != hipSuccess || hipDeviceGetAttribute(&cus, hipDeviceAttributeMultiprocessorCount, dev) != hipSuccess) { grid = -1; return; }
        if (hipFuncSetAttribute((const void*)mk_fwd, hipFuncAttributeMaxDynamicSharedMemorySize, LDS_BYTES) != hipSuccess) { fprintf(stderr, "kernel_launch: hipFuncSetAttribute failed\n"); grid = -1; return; }
        if (hipOccupancyMaxActiveBlocksPerMultiprocessor(&per_cu, (const void*)mk_fwd, NTHREADS, LDS_BYTES) != hipSuccess || per_cu < 1) { fprintf(stderr, "kernel_launch: occupancy query says %d\n", per_cu); per_cu = 1; }
        (void)hipGetLastError();
        grid = cus * 1;
    }
    if (grid < 0) return;
    (void)hipMemsetAsync((char*)d_ws + WS_MISC + MISC_CTL, 0, CTL_BYTES, stream);
    Args a{};
    for (int i = 0; i < 16; ++i) a.in[i] = (const float*)d_in[i];
    a.out = (float*)d_out; a.ws = (unsigned char*)d_ws;
#if MK_SPLIT
    for (int ph = 0; ph < NPHASES; ++ph) { a.ph_lo = ph; a.ph_hi = ph + 1; hipLaunchKernelGGL(mk_fwd, dim3(grid), dim3(NTHREADS), LDS_BYTES, stream, a); }
#else
    a.ph_lo = 0; a.ph_hi = NPHASES;
    void* args[] = {&a};
    hipError_t e = hipLaunchCooperativeKernel((const void*)mk_fwd, dim3(grid), dim3(NTHREADS), args, LDS_BYTES, stream);
    if (e != hipSuccess) fprintf(stderr, "kernel_launch: cooperative launch failed: %s (grid %d)\n", hipGetErrorString(e), grid);
#endif
}
```
